# Optimizing an MI355X kernel written in HIP

```python
import jax, jax.numpy as jnp
from jax import lax
import numpy as np

D_MODEL = 1024
BATCH = 4
SEQ = 8192
DEPTH = 1

HEAD_DIM = 64
N_Q_HEADS = 8
N_KV_HEADS = 2
Q_PER_KV = N_Q_HEADS // N_KV_HEADS
ATTN_WIDTH = N_Q_HEADS * HEAD_DIM
KV_WIDTH = N_KV_HEADS * HEAD_DIM
WINDOW = 128
BLOCK = 128
N_BUCKETS = 32
MAX_DISTANCE = 128

SSM_HEAD_DIM = 64
SSM_HEADS = 8
SSM_GROUPS = 2
HEADS_PER_GROUP = SSM_HEADS // SSM_GROUPS
SSM_WIDTH = SSM_HEADS * SSM_HEAD_DIM
D_STATE = 128
CONV_K = 4
CHUNK = 128
XBC_WIDTH = SSM_WIDTH + 2 * SSM_GROUPS * D_STATE

MIX_WIDTH = ATTN_WIDTH + SSM_WIDTH
IN_WIDTH = ATTN_WIDTH + 2 * KV_WIDTH + SSM_WIDTH + XBC_WIDTH + SSM_HEADS
D_FF = -(-8 * D_MODEL // (3 * 256)) * 256
EPS = 1e-6

kernel_name = "hymba_swa_sink_ssd_adaln_block"


def rmsnorm(x, g):
    xf = x.astype(jnp.float32)
    y = xf * lax.rsqrt(jnp.mean(xf * xf, axis=-1, keepdims=True) + EPS)
    return (y * g.astype(jnp.float32)).astype(x.dtype)


def t5_buckets(dist):
    n = np.maximum(dist, 0)
    max_exact = N_BUCKETS // 2
    large = max_exact + (np.log(np.maximum(n, 1) / max_exact) / np.log(MAX_DISTANCE / max_exact)
                         * (N_BUCKETS - max_exact)).astype(np.int32)
    large = np.minimum(large, N_BUCKETS - 1)
    return np.where(n < max_exact, n, large).astype(np.int32)


def sliding_window_attention(q, k, v, sinks, rel_bias):
    b, s, _ = q.shape
    nb = s // BLOCK
    qb = q.reshape(b, nb, BLOCK, N_KV_HEADS, Q_PER_KV, HEAD_DIM)

    def band(t):
        t = t.reshape(b, s, N_KV_HEADS, HEAD_DIM)
        t = jnp.pad(t, ((0, 0), (BLOCK, 0), (0, 0), (0, 0)))
        t = t.reshape(b, nb + 1, BLOCK, N_KV_HEADS, HEAD_DIM)
        return jnp.concatenate([t[:, :-1], t[:, 1:]], axis=2)

    kb, vb = band(k), band(v)
    dist = np.arange(BLOCK)[:, None] + BLOCK - np.arange(2 * BLOCK)[None, :]
    key_pos = np.arange(nb)[:, None] * BLOCK - BLOCK + np.arange(2 * BLOCK)[None, :]
    mask = ((dist >= 0) & (dist < WINDOW))[None] & (key_pos >= 0)[:, None, :]
    mask = mask.reshape(nb, 1, 1, BLOCK, 2 * BLOCK)
    bias = rel_bias.astype(jnp.float32)[t5_buckets(dist)]
    bias = jnp.transpose(bias, (2, 0, 1)).reshape(N_KV_HEADS, Q_PER_KV, BLOCK, 2 * BLOCK)

    scores = jnp.einsum("bnqkgd,bnskd->bnkgqs", qb, kb).astype(jnp.float32)
    scores = scores * (HEAD_DIM ** -0.5) + bias
    scores = jnp.where(mask, scores, -jnp.inf)
    sink = sinks.astype(jnp.float32).reshape(N_KV_HEADS, Q_PER_KV, 1, 1)
    m = jnp.maximum(jnp.max(scores, axis=-1, keepdims=True), sink)
    p = jnp.exp(scores - m)
    denom = jnp.sum(p, axis=-1, keepdims=True) + jnp.exp(sink - m)
    out = jnp.einsum("bnkgqs,bnskd->bnkgqd", p, vb.astype(jnp.float32)) / denom
    out = jnp.transpose(out, (0, 1, 4, 2, 3, 5)).reshape(b, s, ATTN_WIDTH)
    return out.astype(q.dtype)


def ssd_scan(xs, dt, A, Bm, Cm, D_skip):
    b, s = xs.shape[:2]
    nc = s // CHUNK
    xs = xs.astype(jnp.float32)
    xdt = xs * dt[..., None]
    xc = xdt.reshape(b, nc, CHUNK, SSM_GROUPS, HEADS_PER_GROUP, SSM_HEAD_DIM)
    Bc = Bm.astype(jnp.float32).reshape(b, nc, CHUNK, SSM_GROUPS, D_STATE)
    Cc = Cm.astype(jnp.float32).reshape(b, nc, CHUNK, SSM_GROUPS, D_STATE)
    dtA = (dt * A).reshape(b, nc, CHUNK, SSM_GROUPS, HEADS_PER_GROUP)
    Acs = jnp.cumsum(jnp.moveaxis(dtA, 2, -1), axis=-1)

    causal = np.tril(np.ones((CHUNK, CHUNK), dtype=bool))
    seg = Acs[..., :, None] - Acs[..., None, :]
    Lmat = jnp.exp(jnp.where(causal, seg, -jnp.inf))
    CB = jnp.einsum("bclgn,bcsgn->bcgls", Cc, Bc)
    W = CB[:, :, :, None] * Lmat
    y_diag = jnp.einsum("bcgrls,bcsgrp->bclgrp", W, xc)

    decay_states = jnp.exp(Acs[..., -1:] - Acs)
    states = jnp.einsum("bclgn,bcgrl,bclgrp->bcgrpn", Bc, decay_states, xc)
    chunk_decay = jnp.exp(Acs[..., -1])

    def step(h, inp):
        s_c, d_c = inp
        return h * d_c[..., None, None] + s_c, h

    h0 = jnp.zeros((b, SSM_GROUPS, HEADS_PER_GROUP, SSM_HEAD_DIM, D_STATE), jnp.float32)
    _, prev = lax.scan(step, h0, (jnp.moveaxis(states, 1, 0), jnp.moveaxis(chunk_decay, 1, 0)))
    prev = jnp.moveaxis(prev, 0, 1)
    y_off = jnp.einsum("bclgn,bcgrpn,bcgrl->bclgrp", Cc, prev, jnp.exp(Acs))

    y = (y_diag + y_off).reshape(b, s, SSM_GROUPS, HEADS_PER_GROUP, SSM_HEAD_DIM)
    y = y + D_skip.astype(jnp.float32)[:, :, None] * xs
    return y


def hybrid_mixer(h, w_in, conv_w, conv_b, dt_bias, A_log, D_skip, sinks,
                 attn_out_norm, ssm_out_norm, w_o, rel_bias):
    b, s, _ = h.shape
    proj = h @ w_in
    o1 = ATTN_WIDTH
    o2 = o1 + KV_WIDTH
    o3 = o2 + KV_WIDTH
    o4 = o3 + SSM_WIDTH
    o5 = o4 + XBC_WIDTH
    q, k, v = proj[..., :o1], proj[..., o1:o2], proj[..., o2:o3]
    z, xbc, dt_raw = proj[..., o3:o4], proj[..., o4:o5], proj[..., o5:]

    y_attn = sliding_window_attention(q, k, v, sinks, rel_bias)
    y_attn = rmsnorm(y_attn, attn_out_norm)

    xbc = lax.conv_general_dilated(xbc, conv_w[:, None, :], window_strides=(1,),
                                   padding=[(CONV_K - 1, 0)],
                                   dimension_numbers=("NWC", "WIO", "NWC"),
                                   feature_group_count=XBC_WIDTH)
    xbc = jax.nn.silu(xbc + conv_b)
    xs = xbc[..., :SSM_WIDTH].reshape(b, s, SSM_GROUPS, HEADS_PER_GROUP, SSM_HEAD_DIM)
    Bm = xbc[..., SSM_WIDTH:SSM_WIDTH + SSM_GROUPS * D_STATE].reshape(b, s, SSM_GROUPS, D_STATE)
    Cm = xbc[..., SSM_WIDTH + SSM_GROUPS * D_STATE:].reshape(b, s, SSM_GROUPS, D_STATE)
    dt = jax.nn.softplus(dt_raw.astype(jnp.float32) + dt_bias.astype(jnp.float32))
    dt = dt.reshape(b, s, SSM_GROUPS, HEADS_PER_GROUP)
    A = -jnp.exp(A_log.astype(jnp.float32)).reshape(SSM_GROUPS, HEADS_PER_GROUP)
    y_ssm = ssd_scan(xs, dt, A, Bm, Cm, D_skip.reshape(SSM_GROUPS, HEADS_PER_GROUP))
    y_ssm = y_ssm.reshape(b, s, SSM_GROUPS, SSM_WIDTH // SSM_GROUPS)
    gz = jax.nn.silu(z.astype(jnp.float32)).reshape(b, s, SSM_GROUPS, SSM_WIDTH // SSM_GROUPS)
    y_ssm = rmsnorm(y_ssm * gz, ssm_out_norm.reshape(SSM_GROUPS, SSM_WIDTH // SSM_GROUPS))
    y_ssm = y_ssm.reshape(b, s, SSM_WIDTH).astype(h.dtype)

    return jnp.concatenate([y_attn, y_ssm], axis=-1) @ w_o


def swiglu(h, w_gate_up, w_down):
    gu = h @ w_gate_up
    g, u = gu[..., :D_FF], gu[..., D_FF:]
    return (jax.nn.silu(g) * u) @ w_down


def setup_inputs(seed: int = 0) -> dict:
    key = jax.random.key(seed)
    ks = jax.random.split(key, 24)
    f32 = jnp.float32
    nrm = lambda k, shape, sc: jax.random.normal(k, shape, f32) * sc
    dt = jnp.exp(jax.random.uniform(ks[8], (DEPTH, SSM_HEADS), f32)
                 * (jnp.log(0.1) - jnp.log(0.001)) + jnp.log(0.001))
    return {
        "x": nrm(ks[0], (BATCH, SEQ, D_MODEL), 1.0),
        "c": nrm(ks[1], (BATCH, D_MODEL), 1.0),
        "ada_w": nrm(ks[2], (DEPTH, D_MODEL, 6 * D_MODEL), D_MODEL ** -0.5),
        "ada_b": nrm(ks[3], (DEPTH, 6 * D_MODEL), 0.01),
        "norm1": 1.0 + nrm(ks[4], (DEPTH, D_MODEL), 0.01),
        "w_in": nrm(ks[5], (DEPTH, D_MODEL, IN_WIDTH), D_MODEL ** -0.5),
        "conv_w": nrm(ks[6], (DEPTH, CONV_K, XBC_WIDTH), CONV_K ** -0.5),
        "conv_b": nrm(ks[7], (DEPTH, XBC_WIDTH), 0.01),
        "dt_bias": dt + jnp.log(-jnp.expm1(-dt)),
        "A_log": jnp.log(jax.random.uniform(ks[9], (DEPTH, SSM_HEADS), f32, 1.0, 16.0)),
        "D_skip": 1.0 + nrm(ks[10], (DEPTH, SSM_HEADS), 0.1),
        "sinks": nrm(ks[11], (DEPTH, N_Q_HEADS), 0.5),
        "attn_out_norm": 1.0 + nrm(ks[12], (DEPTH, ATTN_WIDTH), 0.01),
        "ssm_out_norm": 1.0 + nrm(ks[13], (DEPTH, SSM_WIDTH), 0.01),
        "w_o": nrm(ks[14], (DEPTH, MIX_WIDTH, D_MODEL), MIX_WIDTH ** -0.5),
        "norm2": 1.0 + nrm(ks[15], (DEPTH, D_MODEL), 0.01),
        "w_gate_up": nrm(ks[16], (DEPTH, D_MODEL, 2 * D_FF), D_MODEL ** -0.5),
        "w_down": nrm(ks[17], (DEPTH, D_FF, D_MODEL), D_FF ** -0.5),
        "rel_bias": nrm(ks[18], (N_BUCKETS, N_Q_HEADS), 0.5),
        "final_norm": 1.0 + nrm(ks[19], (D_MODEL,), 0.01),
    }


def reference(x, c, ada_w, ada_b, norm1, w_in, conv_w, conv_b, dt_bias, A_log, D_skip,
              sinks, attn_out_norm, ssm_out_norm, w_o, norm2, w_gate_up, w_down,
              rel_bias, final_norm):
    cond = jax.nn.silu(c)
    for l in range(DEPTH):
        mod = (cond @ ada_w[l] + ada_b[l])[:, None, :]
        shift1, scale1, gate1, shift2, scale2, gate2 = jnp.split(mod, 6, axis=-1)
        h = rmsnorm(x, norm1[l]) * (1.0 + scale1) + shift1
        x = x + gate1 * hybrid_mixer(h, w_in[l], conv_w[l], conv_b[l], dt_bias[l], A_log[l],
                                     D_skip[l], sinks[l], attn_out_norm[l], ssm_out_norm[l],
                                     w_o[l], rel_bias)
        h = rmsnorm(x, norm2[l]) * (1.0 + scale2) + shift2
        x = x + gate2 * swiglu(h, w_gate_up[l], w_down[l])
    return rmsnorm(x, final_norm)
```

```cpp
#include <hip/hip_runtime.h>
#include <cstdio>
#include <cstdint>

constexpr int BATCH = 4, SEQ = 8192, D = 1024, T = BATCH * SEQ;
constexpr int NIN = 2312, DFF = 2816;
constexpr int OQ = 0, OK_ = 512, OV = 640, OZ = 768, OXBC = 1280, ODT = 2304;
constexpr float EPS = 1e-6f;

__device__ const int T5B[128] = {0,1,2,3,4,5,6,7,8,9,10,11,12,13,14,15,16,16,16,17,17,18,18,18,19,19,19,20,20,20,20,21,21,21,21,22,22,22,22,22,23,23,23,23,23,23,24,24,24,24,24,24,25,25,25,25,25,25,25,26,26,26,26,26,26,26,26,27,27,27,27,27,27,27,27,27,27,28,28,28,28,28,28,28,28,28,28,29,29,29,29,29,29,29,29,29,29,29,29,30,30,30,30,30,30,30,30,30,30,30,30,30,30,31,31,31,31,31,31,31,31,31,31,31,31,31,31,31};

__device__ __forceinline__ float silu_f(float v) { return v / (1.f + expf(-v)); }
__device__ __forceinline__ float softplus_f(float v) { return fmaxf(v, 0.f) + log1pf(expf(-fabsf(v))); }

__device__ __forceinline__ float wave_sum(float v) {
#pragma unroll
    for (int o = 1; o < 64; o <<= 1) v += __shfl_xor(v, o);
    return v;
}

__global__ void __launch_bounds__(256) k_ada(const float* __restrict__ c, const float* __restrict__ w, const float* __restrict__ bias, float* __restrict__ mod) {
    __shared__ float cs[4][1024];
    for (int i = threadIdx.x; i < 4096; i += 256) cs[i >> 10][i & 1023] = silu_f(c[i]);
    __syncthreads();
    const int j = blockIdx.x * 256 + threadIdx.x;
    float a0 = 0, a1 = 0, a2 = 0, a3 = 0;
    for (int k = 0; k < 1024; ++k) { const float wv = w[(size_t)k * 6144 + j]; a0 += cs[0][k] * wv; a1 += cs[1][k] * wv; a2 += cs[2][k] * wv; a3 += cs[3][k] * wv; }
    const float bb = bias[j];
    mod[j] = a0 + bb; mod[6144 + j] = a1 + bb; mod[2 * 6144 + j] = a2 + bb; mod[3 * 6144 + j] = a3 + bb;
}

__global__ void __launch_bounds__(256) k_rmsnorm(const float* in, float* out, const float* __restrict__ g, const float* __restrict__ mod, int scale_off, int shift_off) {
    __shared__ float red[4];
    const int t = blockIdx.x, b = t / SEQ, tid = threadIdx.x;
    const float4 v = ((const float4*)(in + (size_t)t * D))[tid];
    float s = v.x * v.x + v.y * v.y + v.z * v.z + v.w * v.w;
    s = wave_sum(s);
    if ((tid & 63) == 0) red[tid >> 6] = s;
    __syncthreads();
    const float tot = red[0] + red[1] + red[2] + red[3];
    const float rstd = rsqrtf(tot * (1.f / D) + EPS);
    const float4 gv = ((const float4*)g)[tid];
    float4 o = {v.x * rstd * gv.x, v.y * rstd * gv.y, v.z * rstd * gv.z, v.w * rstd * gv.w};
    if (mod) {
        const float4 sc = ((const float4*)(mod + b * 6144 + scale_off))[tid];
        const float4 sh = ((const float4*)(mod + b * 6144 + shift_off))[tid];
        o.x = o.x * (1.f + sc.x) + sh.x; o.y = o.y * (1.f + sc.y) + sh.y; o.z = o.z * (1.f + sc.z) + sh.z; o.w = o.w * (1.f + sc.w) + sh.w;
    }
    ((float4*)(out + (size_t)t * D))[tid] = o;
}

template <int EPI>
__global__ void __launch_bounds__(256) k_gemm(const float* __restrict__ A, int lda, const float* __restrict__ B, int ldb, int bcol, float* C, int ldc, int N, int K,
                                              const float* __restrict__ xres, const float* __restrict__ mod, int gate_off) {
    __shared__ float As[16][68];
    __shared__ float Bs[16][68];
    const int tid = threadIdx.x, tx = tid & 15, ty = tid >> 4;
    const int row0 = blockIdx.y * 64, col0 = blockIdx.x * 64;
    float acc[4][4] = {};
    const int ar = tid >> 2, ak = (tid & 3) * 4;
    const int bk = tid >> 4, bn = (tid & 15) * 4;
    for (int k0 = 0; k0 < K; k0 += 16) {
        const float4 av = *(const float4*)(A + (size_t)(row0 + ar) * lda + k0 + ak);
        float4 bv = {0, 0, 0, 0};
        if (col0 + bn < N) bv = *(const float4*)(B + (size_t)(k0 + bk) * ldb + bcol + col0 + bn);
        __syncthreads();
        As[ak + 0][ar] = av.x; As[ak + 1][ar] = av.y; As[ak + 2][ar] = av.z; As[ak + 3][ar] = av.w;
        *(float4*)&Bs[bk][bn] = bv;
        __syncthreads();
#pragma unroll
        for (int k = 0; k < 16; ++k) {
            const float4 a = *(const float4*)&As[k][ty * 4];
            const float4 b = *(const float4*)&Bs[k][tx * 4];
            const float aa[4] = {a.x, a.y, a.z, a.w}, bb[4] = {b.x, b.y, b.z, b.w};
#pragma unroll
            for (int i = 0; i < 4; ++i)
#pragma unroll
                for (int j = 0; j < 4; ++j) acc[i][j] += aa[i] * bb[j];
        }
    }
#pragma unroll
    for (int i = 0; i < 4; ++i) {
        const int r = row0 + ty * 4 + i, bidx = r / SEQ;
#pragma unroll
        for (int j = 0; j < 4; ++j) {
            const int cc = col0 + tx * 4 + j;
            if (cc < N) {
                float* cp = C + (size_t)r * ldc + cc;
                const float a = acc[i][j];
                if (EPI == 0) *cp = a;
                else if (EPI == 1) *cp = xres[(size_t)r * ldc + cc] + mod[bidx * 6144 + gate_off + cc] * a;
                else if (EPI == 3) *cp = silu_f(*cp) * a;
                else if (EPI == 4) *cp = *cp + mod[bidx * 6144 + gate_off + cc] * a;
            }
        }
    }
}

__global__ void __launch_bounds__(128) k_attn(const float* __restrict__ proj, const float* __restrict__ sinks, const float* __restrict__ rel_bias, float* __restrict__ ymix) {
    __shared__ float qs[64];
    __shared__ float ps[128];
    __shared__ float red[2];
    __shared__ float osum[2][64];
    const int t = blockIdx.x >> 3, h = blockIdx.x & 7, kvh = h >> 2, s = t % SEQ, tid = threadIdx.x;
    if (tid < 64) qs[tid] = proj[(size_t)t * NIN + OQ + h * 64 + tid];
    __syncthreads();
    const int kp = s - tid;
    const bool valid = kp >= 0;
    float sc = -INFINITY;
    if (valid) {
        const float* kr = proj + (size_t)(t - tid) * NIN + OK_ + kvh * 64;
        float a = 0.f;
#pragma unroll 8
        for (int d = 0; d < 64; ++d) a += qs[d] * kr[d];
        sc = a * 0.125f + rel_bias[T5B[tid] * 8 + h];
    }
    float m = sc;
#pragma unroll
    for (int o = 1; o < 64; o <<= 1) m = fmaxf(m, __shfl_xor(m, o));
    if ((tid & 63) == 0) red[tid >> 6] = m;
    __syncthreads();
    const float sink = sinks[h];
    m = fmaxf(fmaxf(red[0], red[1]), sink);
    const float p = valid ? expf(sc - m) : 0.f;
    ps[tid] = p;
    float l = wave_sum(p);
    __syncthreads();
    if ((tid & 63) == 0) red[tid >> 6] = l;
    __syncthreads();
    const float denom = red[0] + red[1] + expf(sink - m);
    const int d = tid & 63, half = tid >> 6;
    float o = 0.f;
    for (int i = half * 64; i < half * 64 + 64; ++i) {
        if (s - i >= 0) o += ps[i] * proj[(size_t)(t - i) * NIN + OV + kvh * 64 + d];
    }
    osum[half][d] = o;
    __syncthreads();
    if (tid < 64) ymix[(size_t)t * D + h * 64 + tid] = (osum[0][tid] + osum[1][tid]) / denom;
}

__global__ void __launch_bounds__(256) k_conv(const float* __restrict__ proj, const float* __restrict__ cw, const float* __restrict__ cb, float* __restrict__ xc) {
    const int t = blockIdx.x, s = t % SEQ;
    for (int c = threadIdx.x; c < 1024; c += 256) {
        float a = cb[c];
#pragma unroll
        for (int j = 0; j < 4; ++j) { const int sp = s - 3 + j; if (sp >= 0) a += cw[j * 1024 + c] * proj[(size_t)(t - 3 + j) * NIN + OXBC + c]; }
        xc[(size_t)t * 1024 + c] = silu_f(a);
    }
}

__global__ void __launch_bounds__(64) k_ssd_seq(const float* __restrict__ proj, const float* __restrict__ xc, const float* __restrict__ dt_bias, const float* __restrict__ A_log, const float* __restrict__ D_skip, float* __restrict__ ymix) {
    const int p = blockIdx.x & 63, hd = (blockIdx.x >> 6) & 7, b = blockIdx.x >> 9, g = hd >> 2, lane = threadIdx.x;
    const float A = -expf(A_log[hd]), Dk = D_skip[hd], dtb = dt_bias[hd];
    float h0 = 0.f, h1 = 0.f;
    for (int s0 = 0; s0 < SEQ; s0 += 8) {
        float dtr[8], xv[8], B0[8], B1[8], C0[8], C1[8];
#pragma unroll
        for (int u = 0; u < 8; ++u) {
            const size_t row = (size_t)b * SEQ + s0 + u;
            dtr[u] = proj[row * NIN + ODT + hd];
            xv[u] = xc[row * 1024 + hd * 64 + p];
            B0[u] = xc[row * 1024 + 512 + g * 128 + lane]; B1[u] = xc[row * 1024 + 512 + g * 128 + 64 + lane];
            C0[u] = xc[row * 1024 + 768 + g * 128 + lane]; C1[u] = xc[row * 1024 + 768 + g * 128 + 64 + lane];
        }
#pragma unroll
        for (int u = 0; u < 8; ++u) {
            const float dt = softplus_f(dtr[u] + dtb);
            const float dec = expf(dt * A), xd = xv[u] * dt;
            h0 = h0 * dec + xd * B0[u]; h1 = h1 * dec + xd * B1[u];
            const float y = wave_sum(C0[u] * h0 + C1[u] * h1);
            if (lane == 0) ymix[((size_t)b * SEQ + s0 + u) * D + 512 + hd * 64 + p] = y + Dk * xv[u];
        }
    }
}

__global__ void __launch_bounds__(256) k_mixnorm(const float* __restrict__ proj, const float* __restrict__ ga, const float* __restrict__ gs, float* ymix) {
    __shared__ float red[4];
    const int t = blockIdx.x, tid = threadIdx.x, w = tid >> 6;
    float4 v = ((float4*)(ymix + (size_t)t * D))[tid];
    if (w >= 2) {
        const float4 z = *(const float4*)(proj + (size_t)t * NIN + OZ + (tid - 128) * 4);
        v.x *= silu_f(z.x); v.y *= silu_f(z.y); v.z *= silu_f(z.z); v.w *= silu_f(z.w);
    }
    float s = wave_sum(v.x * v.x + v.y * v.y + v.z * v.z + v.w * v.w);
    if ((tid & 63) == 0) red[w] = s;
    __syncthreads();
    float rstd; float4 gv;
    if (w < 2) { rstd = rsqrtf((red[0] + red[1]) * (1.f / 512.f) + EPS); gv = ((const float4*)ga)[tid]; }
    else { rstd = rsqrtf(red[w] * (1.f / 256.f) + EPS); gv = ((const float4*)gs)[tid - 128]; }
    v.x *= rstd * gv.x; v.y *= rstd * gv.y; v.z *= rstd * gv.z; v.w *= rstd * gv.w;
    ((float4*)(ymix + (size_t)t * D))[tid] = v;
}

extern "C" void kernel_launch(void* const* d_in, const int* in_sizes, int n_in, void* d_out, int out_size, void* d_ws, size_t ws_size, hipStream_t stream) {
    const float* x = (const float*)d_in[0]; const float* c = (const float*)d_in[1]; const float* ada_w = (const float*)d_in[2]; const float* ada_b = (const float*)d_in[3];
    const float* norm1 = (const float*)d_in[4]; const float* w_in = (const float*)d_in[5]; const float* conv_w = (const float*)d_in[6]; const float* conv_b = (const float*)d_in[7];
    const float* dt_bias = (const float*)d_in[8]; const float* A_log = (const float*)d_in[9]; const float* D_skip = (const float*)d_in[10]; const float* sinks = (const float*)d_in[11];
    const float* attn_norm = (const float*)d_in[12]; const float* ssm_norm = (const float*)d_in[13]; const float* w_o = (const float*)d_in[14]; const float* norm2 = (const float*)d_in[15];
    const float* w_gu = (const float*)d_in[16]; const float* w_down = (const float*)d_in[17]; const float* rel_bias = (const float*)d_in[18]; const float* final_norm = (const float*)d_in[19];
    float* out = (float*)d_out;
    char* ws = (char*)d_ws;
    const size_t MiB = 1u << 20;
    float* R0 = (float*)(ws);
    float* PROJ = (float*)(ws + 128 * MiB);
    float* ACT = PROJ;
    float* MOD = (float*)(ws + 500 * MiB);
    if (ws_size < 512 * MiB) { fprintf(stderr, "ws too small\n"); return; }

    k_ada<<<6144 / 256, 256, 0, stream>>>(c, ada_w, ada_b, MOD);
    k_rmsnorm<<<T, 256, 0, stream>>>(x, R0, norm1, MOD, 1024, 0);
    k_gemm<0><<<dim3((NIN + 63) / 64, T / 64), 256, 0, stream>>>(R0, D, w_in, NIN, 0, PROJ, NIN, NIN, D, nullptr, nullptr, 0);
    k_attn<<<T * 8, 128, 0, stream>>>(PROJ, sinks, rel_bias, R0);
    k_conv<<<T, 256, 0, stream>>>(PROJ, conv_w, conv_b, out);
    k_ssd_seq<<<BATCH * 8 * 64, 64, 0, stream>>>(PROJ, out, dt_bias, A_log, D_skip, R0);
    k_mixnorm<<<T, 256, 0, stream>>>(PROJ, attn_norm, ssm_norm, R0);
    k_gemm<1><<<dim3(D / 64, T / 64), 256, 0, stream>>>(R0, D, w_o, D, 0, out, D, D, D, x, MOD, 2048);
    k_rmsnorm<<<T, 256, 0, stream>>>(out, R0, norm2, MOD, 4096, 3072);
    k_gemm<0><<<dim3(DFF / 64, T / 64), 256, 0, stream>>>(R0, D, w_gu, 2 * DFF, 0, ACT, DFF, DFF, D, nullptr, nullptr, 0);
    k_gemm<3><<<dim3(DFF / 64, T / 64), 256, 0, stream>>>(R0, D, w_gu, 2 * DFF, DFF, ACT, DFF, DFF, D, nullptr, nullptr, 0);
    k_gemm<4><<<dim3(D / 64, T / 64), 256, 0, stream>>>(ACT, DFF, w_down, D, 0, out, D, D, DFF, nullptr, MOD, 5120);
    k_rmsnorm<<<T, 256, 0, stream>>>(out, out, final_norm, nullptr, 0, 0);
}
```

```cpp
#include <hip/hip_runtime.h>
#include <cstdio>
#include <cstdint>

constexpr int BATCH = 4, SEQ = 8192, D = 1024, T = BATCH * SEQ;
constexpr int NIN = 2312, NINP = 2560, DFF = 2816, NGU = 2 * DFF;
constexpr int OQ = 0, OK_ = 512, OV = 640, OZ = 768, OXBC = 1280, ODT = 2304;
constexpr float EPS = 1e-6f;
constexpr float LOG2E = 1.4426950408889634f;
constexpr float C2 = 0.125f * LOG2E;

__device__ const int T5B[128] = {0,1,2,3,4,5,6,7,8,9,10,11,12,13,14,15,16,16,16,17,17,18,18,18,19,19,19,20,20,20,20,21,21,21,21,22,22,22,22,22,23,23,23,23,23,23,24,24,24,24,24,24,25,25,25,25,25,25,25,26,26,26,26,26,26,26,26,27,27,27,27,27,27,27,27,27,27,28,28,28,28,28,28,28,28,28,28,29,29,29,29,29,29,29,29,29,29,29,29,30,30,30,30,30,30,30,30,30,30,30,30,30,30,31,31,31,31,31,31,31,31,31,31,31,31,31,31,31};

typedef unsigned short bf16;
__device__ __forceinline__ float bf2f(bf16 v) { return __uint_as_float((unsigned)v << 16); }
__device__ __forceinline__ unsigned f2bf(float f) { unsigned u = __builtin_bit_cast(unsigned, f); return (u + 0x7fffu + ((u >> 16) & 1u)) >> 16; }
__device__ __forceinline__ unsigned pk2(float lo, float hi) { return f2bf(lo) | (f2bf(hi) << 16); }
__device__ __forceinline__ float silu_f(float v) { return v / (1.f + __expf(-v)); }
__device__ __forceinline__ float softplus_f(float v) { return fmaxf(v, 0.f) + log1pf(expf(-fabsf(v))); }
__device__ __forceinline__ float wave_sum(float v) {
#pragma unroll
    for (int o = 1; o < 64; o <<= 1) v += __shfl_xor(v, o);
    return v;
}

constexpr size_t MiB = 1u << 20;
constexpr size_t WS_CTL = 0, CTL_ZERO_BYTES = 64 * 1024;
constexpr size_t WS_MOD = 1 * MiB;
constexpr size_t WS_BIAS1 = WS_MOD + 128 * 1024;
constexpr size_t WS_BIAS2 = WS_BIAS1 + 64 * 1024;
constexpr size_t WS_GM2 = WS_BIAS2 + 128 * 1024;
constexpr size_t WS_RSTD1 = WS_GM2 + 64 * 1024;
constexpr size_t WS_DT = 2 * MiB;
constexpr size_t WS_SS2 = 3 * MiB;
constexpr size_t WS_W1T = 6 * MiB;
constexpr size_t WS_WOT = 12 * MiB;
constexpr size_t WS_WGUT = 14 * MiB;
constexpr size_t WS_WDT = 26 * MiB;
constexpr size_t WS_A = 32 * MiB;
constexpr size_t WS_PROJ = 96 * MiB;
constexpr size_t WS_ACT = 96 * MiB;
constexpr size_t WS_YMIX = 272 * MiB;
constexpr size_t WS_SSD = 336 * MiB;
constexpr size_t WS_END = 512 * MiB;
__global__ void __launch_bounds__(128) k_attn(const bf16* __restrict__ proj, const float* __restrict__ sinks, const float* __restrict__ rel_bias, float* __restrict__ yf) {
    __shared__ float qs[64];
    __shared__ float ps[128];
    __shared__ float red[2];
    __shared__ float osum[2][64];
    const int t = blockIdx.x >> 3, h = blockIdx.x & 7, kvh = h >> 2, s = t % SEQ, tid = threadIdx.x;
    if (tid < 64) qs[tid] = bf2f(proj[(size_t)t * NINP + OQ + h * 64 + tid]) * (1.f / LOG2E);
    __syncthreads();
    const int kp = s - tid;
    const bool valid = kp >= 0;
    float sc = -INFINITY;
    if (valid) {
        const bf16* kr = proj + (size_t)(t - tid) * NINP + OK_ + kvh * 64;
        float a = 0.f;
#pragma unroll 8
        for (int d = 0; d < 64; ++d) a += qs[d] * bf2f(kr[d]);
        sc = a + rel_bias[T5B[tid] * 8 + h];
    }
    float m = sc;
#pragma unroll
    for (int o = 1; o < 64; o <<= 1) m = fmaxf(m, __shfl_xor(m, o));
    if ((tid & 63) == 0) red[tid >> 6] = m;
    __syncthreads();
    const float sink = sinks[h];
    m = fmaxf(fmaxf(red[0], red[1]), sink);
    const float p = valid ? expf(sc - m) : 0.f;
    ps[tid] = p;
    float l = wave_sum(p);
    __syncthreads();
    if ((tid & 63) == 0) red[tid >> 6] = l;
    __syncthreads();
    const float denom = red[0] + red[1] + expf(sink - m);
    const int d = tid & 63, half = tid >> 6;
    float o = 0.f;
    for (int i = half * 64; i < half * 64 + 64; ++i) {
        if (s - i >= 0) o += ps[i] * bf2f(proj[(size_t)(t - i) * NINP + OV + kvh * 64 + d]);
    }
    osum[half][d] = o;
    __syncthreads();
    if (tid < 64) yf[(size_t)t * D + h * 64 + tid] = (osum[0][tid] + osum[1][tid]) / denom;
}

__global__ void __launch_bounds__(256) k_conv(const bf16* __restrict__ proj, const float* __restrict__ cw, const float* __restrict__ cb, float* __restrict__ xc) {
    const int t = blockIdx.x, s = t % SEQ;
    for (int c = threadIdx.x; c < 1024; c += 256) {
        float a = cb[c];
#pragma unroll
        for (int j = 0; j < 4; ++j) { const int sp = s - 3 + j; if (sp >= 0) a += cw[j * 1024 + c] * bf2f(proj[(size_t)(t - 3 + j) * NINP + OXBC + c]); }
        xc[(size_t)t * 1024 + c] = a / (1.f + expf(-a));
    }
}

__global__ void __launch_bounds__(64) k_ssd_seq(const float* __restrict__ dtraw, const float* __restrict__ xc, const float* __restrict__ dt_bias, const float* __restrict__ A_log, const float* __restrict__ D_skip, float* __restrict__ yf) {
    const int p = blockIdx.x & 63, hd = (blockIdx.x >> 6) & 7, b = blockIdx.x >> 9, g = hd >> 2, lane = threadIdx.x;
    const float A = -expf(A_log[hd]), Dk = D_skip[hd], dtb = dt_bias[hd];
    float h0 = 0.f, h1 = 0.f;
    for (int s0 = 0; s0 < SEQ; s0 += 8) {
        float dtr[8], xv[8], B0[8], B1[8], C0[8], C1[8];
#pragma unroll
        for (int u = 0; u < 8; ++u) {
            const size_t row = (size_t)b * SEQ + s0 + u;
            dtr[u] = dtraw[row * 8 + hd];
            xv[u] = xc[row * 1024 + hd * 64 + p];
            B0[u] = xc[row * 1024 + 512 + g * 128 + lane]; B1[u] = xc[row * 1024 + 512 + g * 128 + 64 + lane];
            C0[u] = xc[row * 1024 + 768 + g * 128 + lane]; C1[u] = xc[row * 1024 + 768 + g * 128 + 64 + lane];
        }
#pragma unroll
        for (int u = 0; u < 8; ++u) {
            const float dt = softplus_f(dtr[u] + dtb);
            const float dec = expf(dt * A), xd = xv[u] * dt;
            h0 = h0 * dec + xd * B0[u]; h1 = h1 * dec + xd * B1[u];
            const float y = wave_sum(C0[u] * h0 + C1[u] * h1);
            if (lane == 0) yf[((size_t)b * SEQ + s0 + u) * D + 512 + hd * 64 + p] = y + Dk * xv[u];
        }
    }
}

__global__ void __launch_bounds__(256) k_mixnorm(const bf16* __restrict__ proj, const float* __restrict__ ga, const float* __restrict__ gs, const float* __restrict__ yf, bf16* __restrict__ ymix) {
    __shared__ float red[4];
    const int t = blockIdx.x, tid = threadIdx.x, w = tid >> 6;
    float4 v = ((const float4*)(yf + (size_t)t * D))[tid];
    if (w >= 2) {
        const bf16* zp = proj + (size_t)t * NINP + OZ + (tid - 128) * 4;
        v.x *= silu_f(bf2f(zp[0])); v.y *= silu_f(bf2f(zp[1])); v.z *= silu_f(bf2f(zp[2])); v.w *= silu_f(bf2f(zp[3]));
    }
    float s = wave_sum(v.x * v.x + v.y * v.y + v.z * v.z + v.w * v.w);
    if ((tid & 63) == 0) red[w] = s;
    __syncthreads();
    float rstd; float4 gv;
    if (w < 2) { rstd = rsqrtf((red[0] + red[1]) * (1.f / 512.f) + EPS); gv = ((const float4*)ga)[tid]; }
    else { rstd = rsqrtf(red[w] * (1.f / 256.f) + EPS); gv = ((const float4*)gs)[tid - 128]; }
    uint2 o; o.x = pk2(v.x * rstd * gv.x, v.y * rstd * gv.y); o.y = pk2(v.z * rstd * gv.z, v.w * rstd * gv.w);
    *(uint2*)(ymix + (size_t)t * D + tid * 4) = o;
}
namespace pg8 {
#define PG8_LAS __attribute__((address_space(3)))
typedef unsigned short bf16_t;
typedef short bf16x8 __attribute__((ext_vector_type(8)));
typedef float f32x4 __attribute__((ext_vector_type(4)));
typedef unsigned u32x4 __attribute__((ext_vector_type(4)));
constexpr int BM = 256, BK = 64, HALF = 128, HTB = HALF * BK * 2  , STAGE_BYTES = 8 * HTB, NXCD = 8, WGM = 8;

__host__ __device__ __forceinline__ int lds_byte(int r, int c) { const int st = (r >> 4) * 2 + (c >> 5), rr = r & 15, cc = c & 31, ob = rr * 64 + cc * 2; return st * 1024 + (ob ^ (((ob >> 9) & 1) << 5)); }
__host__ __device__ __forceinline__ void stage_rc(int b, int& R, int& C) { const int st = b / 1024, sb = b % 1024, swz = sb ^ (((sb >> 9) & 1) << 5); R = (st >> 1) * 16 + swz / 64; C = (st & 1) * 32 + (swz % 64) / 2; }
__host__ __device__ __forceinline__ int perm32(int rho) { const int n = rho >> 4, i = rho & 15; return 8 * (i >> 2) + 4 * n + (i & 3); }

struct Unit { int pm, pn; };
struct Gemm { const bf16_t* A; const bf16_t* Bt; int M, N, K; };
__device__ __forceinline__ unsigned cvt_pk_bf16(float lo, float hi) { unsigned r; asm volatile("v_cvt_pk_bf16_f32 %0, %1, %2" : "=v"(r) : "v"(lo), "v"(hi)); return r; }
typedef float f32x2 __attribute__((ext_vector_type(2)));

struct QuadOrder {
    int pA, cntA, startA, cntB, startB;
    __device__ __forceinline__ void init(int N, int vcu) {
        const int nN = N / BM, q = vcu >> 2, j = vcu & 3, base = nN / 4, rem = nN % 4;
        pA = 2 * q;
        cntA = base + (j < rem ? 1 : 0); startA = j * base + (j < rem ? j : rem);
        cntB = base + (j >= 4 - rem ? 1 : 0); startB = j * base + (j > 4 - rem ? j - (4 - rem) : 0);
    }
    __device__ __forceinline__ bool next(int i, Unit& u) const {
        if (i < cntA) { u.pm = pA; u.pn = startA + i; return true; }
        i -= cntA;
        if (i < cntB) { u.pm = pA + 1; u.pn = startB + i; return true; }
        return false;
    }
    __device__ __forceinline__ void a_ready(const Unit&) const {}
    __device__ __forceinline__ void done(const Unit&) const {}
};


struct EpiIn {
    static constexpr bool PERM = true, AFTER_DRAIN = false;
    bf16_t* O; const float* bias; float* DT; const PG8_LAS float* rs;
    __device__ __forceinline__ void operator()(const f32x4 (&acc)[2][2][4][2], const Unit& u, int wr, int wc, int fr, int fq) const {
        const int slot = u.pm & 1, b = u.pm >> 5, rl0 = wr * 64 + fr, colb = u.pn * BM + wc * 32 + 8 * fq;
        const float sc = (u.pn < 2) ? C2 : 1.f;
        f32x4 bv[2][2];
#pragma unroll
        for (int bj = 0; bj < 2; ++bj)
#pragma unroll
            for (int n = 0; n < 2; ++n) bv[bj][n] = *(const f32x4*)(bias + b * NINP + colb + bj * HALF + 4 * n);
#pragma unroll
        for (int ai = 0; ai < 2; ++ai)
#pragma unroll
            for (int m = 0; m < 4; ++m) {
                const int rl = ai * HALF + rl0 + m * 16; const float rstd = rs[slot * 256 + rl]; const size_t r = (size_t)u.pm * BM + rl;
#pragma unroll
                for (int bj = 0; bj < 2; ++bj) {
                    const f32x4 v0 = (acc[ai][bj][m][0] * rstd + bv[bj][0]) * sc, v1 = (acc[ai][bj][m][1] * rstd + bv[bj][1]) * sc;
                    u32x4 w; w.x = cvt_pk_bf16(v0[0], v0[1]); w.y = cvt_pk_bf16(v0[2], v0[3]); w.z = cvt_pk_bf16(v1[0], v1[1]); w.w = cvt_pk_bf16(v1[2], v1[3]);
                    *(u32x4*)(O + r * NINP + colb + bj * HALF) = w;
                    if (bj == 0 && u.pn == 9 && wc == 0 && fq == 0) { *(f32x4*)(DT + r * 8) = v0; *(f32x4*)(DT + r * 8 + 4) = v1; }
                }
            }
    }
};

struct EpiWo {
    static constexpr bool PERM = true, AFTER_DRAIN = false;
    const float* x; float* x1; bf16_t* A2; float* ss; const float* gate; const float* gm2;
    __device__ __forceinline__ void operator()(const f32x4 (&acc)[2][2][4][2], const Unit& u, int wr, int wc, int fr, int fq) const {
        const int b = u.pm >> 5, rl0 = wr * 64 + fr, colb = u.pn * BM + wc * 32 + 8 * fq;
        f32x4 gv[2][2], mv[2][2];
#pragma unroll
        for (int bj = 0; bj < 2; ++bj)
#pragma unroll
            for (int n = 0; n < 2; ++n) { gv[bj][n] = *(const f32x4*)(gate + b * 6144 + colb + bj * HALF + 4 * n); mv[bj][n] = *(const f32x4*)(gm2 + b * 1024 + colb + bj * HALF + 4 * n); }
#pragma unroll
        for (int ai = 0; ai < 2; ++ai)
#pragma unroll
            for (int m = 0; m < 4; ++m) {
                const int rl = ai * HALF + rl0 + m * 16; const size_t r = (size_t)u.pm * BM + rl; float q = 0.f;
#pragma unroll
                for (int bj = 0; bj < 2; ++bj) {
                    const size_t off = r * 1024 + colb + bj * HALF;
                    const f32x4 xa = *(const f32x4*)(x + off), xb = *(const f32x4*)(x + off + 4);
                    const f32x4 o0 = xa + gv[bj][0] * acc[ai][bj][m][0], o1 = xb + gv[bj][1] * acc[ai][bj][m][1];
                    *(f32x4*)(x1 + off) = o0; *(f32x4*)(x1 + off + 4) = o1;
                    q += (o0[0] * o0[0] + o0[1] * o0[1]) + (o0[2] * o0[2] + o0[3] * o0[3]) + (o1[0] * o1[0] + o1[1] * o1[1]) + (o1[2] * o1[2] + o1[3] * o1[3]);
                    const f32x4 a0 = o0 * mv[bj][0], a1 = o1 * mv[bj][1];
                    u32x4 w; w.x = cvt_pk_bf16(a0[0], a0[1]); w.y = cvt_pk_bf16(a0[2], a0[3]); w.z = cvt_pk_bf16(a1[0], a1[1]); w.w = cvt_pk_bf16(a1[2], a1[3]);
                    *(u32x4*)(A2 + off) = w;
                }
                q += __shfl_xor(q, 16); q += __shfl_xor(q, 32);
                if (fq == 0) ss[r * 16 + u.pn * 4 + wc] = q;
            }
    }
};

struct EpiGU {
    static constexpr bool PERM = true, AFTER_DRAIN = false;
    bf16_t* ACT; const float* bias; const PG8_LAS float* rs;
    __device__ __forceinline__ void operator()(const f32x4 (&acc)[2][2][4][2], const Unit& u, int wr, int wc, int fr, int fq) const {
        const int slot = u.pm & 1, b = u.pm >> 5, rl0 = wr * 64 + fr, colb = u.pn * BM + wc * 32 + 8 * fq, ocol = u.pn * HALF + wc * 32 + 8 * fq;
        f32x4 bv[2][2];
#pragma unroll
        for (int bj = 0; bj < 2; ++bj)
#pragma unroll
            for (int n = 0; n < 2; ++n) bv[bj][n] = *(const f32x4*)(bias + b * NGU + colb + bj * HALF + 4 * n);
#pragma unroll
        for (int ai = 0; ai < 2; ++ai)
#pragma unroll
            for (int m = 0; m < 4; ++m) {
                const int rl = ai * HALF + rl0 + m * 16; const float rstd = rs[slot * 256 + rl]; const size_t r = (size_t)u.pm * BM + rl;
                float a[8];
#pragma unroll
                for (int n = 0; n < 2; ++n) {
                    const f32x4 g = acc[ai][0][m][n] * rstd + bv[0][n], uu = acc[ai][1][m][n] * rstd + bv[1][n];
#pragma unroll
                    for (int e = 0; e < 4; ++e) a[4 * n + e] = g[e] * __builtin_amdgcn_rcpf(1.f + __builtin_amdgcn_exp2f(-LOG2E * g[e])) * uu[e];
                }
                u32x4 w; w.x = cvt_pk_bf16(a[0], a[1]); w.y = cvt_pk_bf16(a[2], a[3]); w.z = cvt_pk_bf16(a[4], a[5]); w.w = cvt_pk_bf16(a[6], a[7]);
                *(u32x4*)(ACT + r * DFF + ocol) = w;
            }
    }
};

struct EpiDown {
    static constexpr bool PERM = true, AFTER_DRAIN = false;
    float* xio; const float* gate;
    __device__ __forceinline__ void operator()(const f32x4 (&acc)[2][2][4][2], const Unit& u, int wr, int wc, int fr, int fq) const {
        const int b = u.pm >> 5, rl0 = wr * 64 + fr, colb = u.pn * BM + wc * 32 + 8 * fq;
        f32x4 gv[2][2];
#pragma unroll
        for (int bj = 0; bj < 2; ++bj)
#pragma unroll
            for (int n = 0; n < 2; ++n) gv[bj][n] = *(const f32x4*)(gate + b * 6144 + colb + bj * HALF + 4 * n);
#pragma unroll
        for (int ai = 0; ai < 2; ++ai)
#pragma unroll
            for (int m = 0; m < 4; ++m) {
                const int rl = ai * HALF + rl0 + m * 16; const size_t r = (size_t)u.pm * BM + rl;
#pragma unroll
                for (int bj = 0; bj < 2; ++bj) {
                    const size_t off = r * 1024 + colb + bj * HALF;
                    const f32x4 xa = *(const f32x4*)(xio + off), xb = *(const f32x4*)(xio + off + 4);
                    *(f32x4*)(xio + off) = xa + gv[bj][0] * acc[ai][bj][m][0]; *(f32x4*)(xio + off + 4) = xb + gv[bj][1] * acc[ai][bj][m][1];
                }
            }
    }
};

template <class Epi, class Sched, bool ALIGN_EPI = false, bool SP2 = false>
__device__ __forceinline__ void gemm_phase(PG8_LAS unsigned char* lds, const Gemm g, const Sched& S, const Epi& E) {
    const int tid = threadIdx.x, wid = __builtin_amdgcn_readfirstlane(tid >> 6), lane = tid & 63, wr = wid >> 2, wc = wid & 3, fr = lane & 15, fq = lane >> 4;
    const int K = g.K, nt = K / BK;
    unsigned voffA[2], voffB[2];
#pragma unroll
    for (int i = 0; i < 2; ++i) { int R, C; stage_rc(tid * 16 + i * 8192, R, C); const int Rb = Epi::PERM ? ((R & ~31) + perm32(R & 31)) : R;
        voffA[i] = (unsigned)(R * K + C) * 2u; voffB[i] = (unsigned)(Rb * K + C) * 2u; }
    const size_t kstep = (size_t)(BK * 2);
    const size_t hstep = (size_t)HALF * K * 2;
    const size_t tstep = 2 * hstep;
    const unsigned ldsw = (unsigned)wid * 1024u;
    const int aoff = lds_byte(wr * 64 + fr, fq * 8), boff = lds_byte(wc * 32 + fr, fq * 8);
#define PG8_SA(b, h) (((b) * 2 + (h)) * HTB)
#define PG8_SB(b, h) ((4 + (b) * 2 + (h)) * HTB)
#define PG8_STAGE(bufoff, gbase, voff) do { _Pragma("unroll") for (int _i = 0; _i < 2; ++_i) \
        __builtin_amdgcn_global_load_lds((const unsigned*)((const char*)(gbase) + (voff)[_i]), (PG8_LAS unsigned*)(lds + (bufoff) + ldsw + _i * 8192), 16, 0, 0); } while (0)
#define PG8_LDA(dst, b, h) do { _Pragma("unroll") for (int m = 0; m < 4; ++m) _Pragma("unroll") for (int k = 0; k < 2; ++k) dst[m][k] = *(const PG8_LAS bf16x8*)(lds + PG8_SA(b, h) + aoff + m * 2048 + k * 1024); } while (0)
#define PG8_LDB(dst, b, h) do { _Pragma("unroll") for (int n = 0; n < 2; ++n) _Pragma("unroll") for (int k = 0; k < 2; ++k) dst[n][k] = *(const PG8_LAS bf16x8*)(lds + PG8_SB(b, h) + boff + n * 2048 + k * 1024); } while (0)
#define PG8_MMA(ai, bj, At, Bt) do { __builtin_amdgcn_s_setprio(1); _Pragma("unroll") for (int m = 0; m < 4; ++m) _Pragma("unroll") for (int n = 0; n < 2; ++n) _Pragma("unroll") for (int k = 0; k < 2; ++k) \
        acc[ai][bj][m][n] = __builtin_amdgcn_mfma_f32_16x16x32_bf16(Bt[n][k], At[m][k], acc[ai][bj][m][n], 0, 0, 0); __builtin_amdgcn_s_setprio(0); } while (0)
#define PG8_WAIT_V(n) asm volatile("s_waitcnt vmcnt(" #n ")" ::: "memory")
#define PG8_WAIT_L(n) asm volatile("s_waitcnt lgkmcnt(" #n ")" ::: "memory")
#define PG8_BAR __builtin_amdgcn_s_barrier()
#define PG8_SCHED __builtin_amdgcn_sched_barrier(0)
    Unit cur, nxt; int ui = 0;
    if (!S.next(0, cur)) return;
    f32x4 acc[2][2][4][2];
#pragma unroll
    for (int a = 0; a < 2; ++a)
#pragma unroll
        for (int b = 0; b < 2; ++b)
#pragma unroll
            for (int m = 0; m < 4; ++m)
#pragma unroll
                for (int n = 0; n < 2; ++n) acc[a][b][m][n] = (f32x4){0.f, 0.f, 0.f, 0.f};
    bf16x8 At[4][2], B0[2][2], B1[2][2];
    const char* cA = (const char*)g.A + (size_t)cur.pm * tstep; const char* cB = (const char*)g.Bt + (size_t)cur.pn * tstep;
    S.a_ready(cur);
    if constexpr (SP2) {
        PG8_STAGE(PG8_SB(0, 0), cB, voffB); PG8_STAGE(PG8_SB(0, 1), cB + hstep, voffB); PG8_STAGE(PG8_SA(0, 0), cA, voffA); PG8_STAGE(PG8_SA(0, 1), cA + hstep, voffA);
        if (wr == 1) PG8_BAR;
        PG8_WAIT_V(2); PG8_BAR;
        PG8_STAGE(PG8_SB(1, 0), cB + kstep, voffB); PG8_STAGE(PG8_SA(1, 0), cA + kstep, voffA); PG8_STAGE(PG8_SB(1, 1), cB + hstep + kstep, voffB);
        PG8_WAIT_V(6); PG8_BAR;
    } else {
        PG8_STAGE(PG8_SB(0, 0), cB, voffB); PG8_STAGE(PG8_SA(0, 0), cA, voffA); PG8_STAGE(PG8_SB(0, 1), cB + hstep, voffB); PG8_STAGE(PG8_SA(0, 1), cA + hstep, voffA);
        if (wr == 1) PG8_BAR;
        PG8_WAIT_V(4); PG8_BAR;
        PG8_STAGE(PG8_SB(1, 0), cB + kstep, voffB); PG8_STAGE(PG8_SA(1, 0), cA + kstep, voffA); PG8_STAGE(PG8_SB(1, 1), cB + hstep + kstep, voffB);
        PG8_WAIT_V(6); PG8_BAR;
    }
    for (;;) {
        const bool has_next = S.next(ui + 1, nxt);
        const char* nA = has_next ? (const char*)g.A + (size_t)nxt.pm * tstep : cA; const char* nB = has_next ? (const char*)g.Bt + (size_t)nxt.pn * tstep : cB;
        for (int t = 0; t < nt; t += 2) {
            const bool last = (t == nt - 2);
            const char* a1 = cA + (size_t)(t + 1) * kstep;
            const char* a2 = last ? nA : cA + (size_t)(t + 2) * kstep; const char* b2 = last ? nB : cB + (size_t)(t + 2) * kstep;
            const char* a3 = a2 + kstep; const char* b3 = b2 + kstep;
            if (last && has_next) S.a_ready(nxt);
            if constexpr (SP2) {
            PG8_LDB(B0, 0, 0); PG8_LDB(B1, 0, 1); PG8_SCHED; PG8_LDA(At, 0, 0); PG8_STAGE(PG8_SA(1, 1), a1 + hstep, voffA);
            PG8_WAIT_V(8); PG8_WAIT_L(0); PG8_BAR; PG8_MMA(0, 0, At, B0); PG8_MMA(0, 1, At, B1); PG8_BAR; PG8_SCHED;
            PG8_LDA(At, 0, 1); PG8_STAGE(PG8_SB(0, 0), b2, voffB); PG8_STAGE(PG8_SB(0, 1), b2 + hstep, voffB); PG8_STAGE(PG8_SA(0, 0), a2, voffA);
            PG8_WAIT_V(8); PG8_WAIT_L(0); PG8_BAR; PG8_MMA(1, 0, At, B0); PG8_MMA(1, 1, At, B1); PG8_BAR; PG8_SCHED;
            PG8_LDB(B0, 1, 0); PG8_LDB(B1, 1, 1); PG8_SCHED; PG8_LDA(At, 1, 0); PG8_STAGE(PG8_SA(0, 1), a2 + hstep, voffA);
            PG8_WAIT_V(8); PG8_WAIT_L(0); PG8_BAR; PG8_MMA(0, 0, At, B0); PG8_MMA(0, 1, At, B1); PG8_BAR; PG8_SCHED;
            PG8_LDA(At, 1, 1); PG8_STAGE(PG8_SB(1, 0), b3, voffB); PG8_STAGE(PG8_SB(1, 1), b3 + hstep, voffB); PG8_STAGE(PG8_SA(1, 0), a3, voffA);
            PG8_WAIT_V(8); PG8_WAIT_L(0); PG8_BAR; PG8_MMA(1, 0, At, B0); PG8_MMA(1, 1, At, B1); PG8_BAR; PG8_SCHED;
            } else {
            PG8_LDB(B0, 0, 0); PG8_SCHED; PG8_LDA(At, 0, 0); PG8_STAGE(PG8_SA(1, 1), a1 + hstep, voffA);
            PG8_WAIT_L(8); PG8_BAR; PG8_WAIT_L(0); PG8_MMA(0, 0, At, B0); PG8_BAR; PG8_SCHED;
            PG8_LDB(B1, 0, 1); PG8_STAGE(PG8_SB(0, 0), b2, voffB);
            PG8_BAR; PG8_WAIT_L(0); PG8_MMA(0, 1, At, B1); PG8_BAR;
            PG8_LDA(At, 0, 1); PG8_STAGE(PG8_SA(0, 0), a2, voffA);
            PG8_BAR; PG8_WAIT_L(0); PG8_MMA(1, 0, At, B0); PG8_BAR; PG8_SCHED;
            PG8_STAGE(PG8_SB(0, 1), b2 + hstep, voffB);
            PG8_WAIT_V(6); PG8_BAR; PG8_MMA(1, 1, At, B1); PG8_BAR;
            PG8_LDB(B0, 1, 0); PG8_SCHED; PG8_LDA(At, 1, 0); PG8_STAGE(PG8_SA(0, 1), a2 + hstep, voffA);
            PG8_WAIT_L(8); PG8_BAR; PG8_WAIT_L(0); PG8_MMA(0, 0, At, B0); PG8_BAR; PG8_SCHED;
            PG8_LDB(B1, 1, 1); PG8_STAGE(PG8_SB(1, 0), b3, voffB);
            PG8_BAR; PG8_WAIT_L(0); PG8_MMA(0, 1, At, B1); PG8_BAR;
            PG8_LDA(At, 1, 1); PG8_STAGE(PG8_SA(1, 0), a3, voffA);
            PG8_BAR; PG8_WAIT_L(0); PG8_MMA(1, 0, At, B0); PG8_BAR; PG8_SCHED;
            PG8_STAGE(PG8_SB(1, 1), b3 + hstep, voffB);
            PG8_WAIT_V(6); PG8_BAR; PG8_MMA(1, 1, At, B1); PG8_BAR;
            }
        }
        if constexpr (ALIGN_EPI) { if (wr == 0) PG8_BAR; }
        if constexpr (!Epi::AFTER_DRAIN) { E(acc, cur, wr, wc, fr, fq); S.done(cur); }
        if (!has_next) break;
#pragma unroll
        for (int a = 0; a < 2; ++a)
#pragma unroll
            for (int b = 0; b < 2; ++b)
#pragma unroll
                for (int m = 0; m < 4; ++m)
#pragma unroll
                    for (int n = 0; n < 2; ++n) acc[a][b][m][n] = (f32x4){0.f, 0.f, 0.f, 0.f};
        cur = nxt; cA = nA; cB = nB; ++ui;
        if constexpr (ALIGN_EPI) { if (wr == 1) PG8_BAR; }
    }
    PG8_WAIT_V(0);
    if constexpr (!ALIGN_EPI) { if (wr == 0) PG8_BAR; }
    PG8_BAR;
    if constexpr (Epi::AFTER_DRAIN) { E.fused(acc, cur, wr, wc, fr, fq, lds, wid, lane); S.done(cur); }
#undef PG8_SA
#undef PG8_SB
#undef PG8_STAGE
#undef PG8_LDA
#undef PG8_LDB
#undef PG8_MMA
#undef PG8_WAIT_V
#undef PG8_WAIT_L
#undef PG8_BAR
#undef PG8_SCHED
}
}
#define GAS __attribute__((address_space(1)))
#define LAS __attribute__((address_space(3)))
typedef unsigned short bf16;
typedef unsigned v4u __attribute__((ext_vector_type(4)));
typedef float f32x4 __attribute__((ext_vector_type(4)));
typedef short bf16x8 __attribute__((ext_vector_type(8)));
typedef GAS unsigned gu32;
typedef GAS unsigned long long gu64;
#define RLX_AGENT __ATOMIC_RELAXED, __HIP_MEMORY_SCOPE_AGENT
#define LDS_WAIT() asm volatile("s_waitcnt lgkmcnt(0)" ::: "memory")
#define VM_WAIT() asm volatile("s_waitcnt vmcnt(0)" ::: "memory")
__device__ __forceinline__ unsigned long long rt() { return __builtin_amdgcn_s_memrealtime(); }

#define XB_TMO      128
#define XB_XCNT(j)  (256  + 64 * (j))
#define XB_XSUB(j)  (1280 + 64 * (j))
#define XB_XGEN(j)  (2304 + 64 * (j))
#define XB_TOP      3328
#define XB_TOPGEN   3392
#define XCD_BAR_WORDS 3456
#define XB_SPIN_CAP (1u << 18)

__device__ __forceinline__ unsigned xb_ld(unsigned* p)              { return __hip_atomic_load(p, __ATOMIC_RELAXED, __HIP_MEMORY_SCOPE_AGENT); }
__device__ __forceinline__ unsigned xb_add(unsigned* p, unsigned v) { return __hip_atomic_fetch_add(p, v, __ATOMIC_RELAXED, __HIP_MEMORY_SCOPE_AGENT); }
__device__ __forceinline__ unsigned xb_xcc_id() { return (unsigned)__builtin_amdgcn_s_getreg((3 << 11) | 20) & 0xFu; }
#define XB_SPIN(cond, bar) do { unsigned _sp = 0; while (cond) { __builtin_amdgcn_s_sleep(1); \
    if ((++_sp & 255u) == 0u) { if (xb_ld(&(bar)[XB_TMO])) break; if (_sp > XB_SPIN_CAP) { atomicAdd(&(bar)[XB_TMO], 1u); break; } } } } while (0)

struct XcdBarrier {
    unsigned* bar; unsigned x;
    volatile LAS unsigned* st;
};

__device__ __forceinline__ XcdBarrier xcd_barrier_post(unsigned* bar, volatile LAS unsigned* st) {
    XcdBarrier b; b.bar = bar; b.x = xb_xcc_id(); b.st = st;
    if (threadIdx.x == 0) (void)xb_add(&bar[XB_XCNT(b.x)], 1u);
    return b;
}
__device__ __forceinline__ void xcd_barrier_complete(unsigned* bar, unsigned x, unsigned& nloc, unsigned& nx) {
    const unsigned G = gridDim.x * gridDim.y * gridDim.z;
    unsigned sum, cnt, mine, sp = 0u;
    for (;;) {
        sum = 0u; cnt = 0u; mine = 0u;
#pragma unroll
        for (unsigned j = 0; j < 16; ++j) { const unsigned c = xb_ld(&bar[XB_XCNT(j)]); sum += c; cnt += (c > 0u) ? 1u : 0u; mine = (j == x) ? c : mine; }
        if (sum == G) break;
        __builtin_amdgcn_s_sleep(1);
        if ((++sp & 255u) == 0u) { if (xb_ld(&bar[XB_TMO])) break; if (sp > XB_SPIN_CAP) { atomicAdd(&bar[XB_TMO], 1u); break; } }
    }
    nloc = mine > 0u ? mine : 1u; nx = cnt > 0u ? cnt : 1u;
}

__device__ __forceinline__ void xcd_barrier(const XcdBarrier& b) {
    asm volatile("s_waitcnt vmcnt(0)" ::: "memory");
    __syncthreads();
    if (threadIdx.x == 0) {
        unsigned* bar = b.bar;
        __builtin_amdgcn_s_waitcnt(0);
        unsigned nloc = b.st[0], nx = b.st[1];
        if (nloc == 0u) { xcd_barrier_complete(bar, b.x, nloc, nx); b.st[0] = nloc; b.st[1] = nx; }
        const unsigned old = xb_add(&bar[XB_XSUB(b.x)], 1u);
        const unsigned gen = old / nloc;
        if (old + 1u == (gen + 1u) * nloc) {
            __builtin_amdgcn_fence(__ATOMIC_RELEASE, "agent");
            asm volatile("s_waitcnt vmcnt(0)" ::: "memory");
            const unsigned og = xb_add(&bar[XB_TOP], 1u);
            const unsigned tg = og / nx;
            if (og + 1u == (tg + 1u) * nx) xb_add(&bar[XB_TOPGEN], 1u);
            else XB_SPIN(xb_ld(&bar[XB_TOPGEN]) == tg, bar);
            __builtin_amdgcn_fence(__ATOMIC_ACQUIRE, "agent");
            xb_add(&bar[XB_XGEN(b.x)], 1u);
            asm volatile("s_waitcnt vmcnt(0)" ::: "memory");
        } else {
            XB_SPIN(xb_ld(&bar[XB_XGEN(b.x)]) == gen, bar);
            __builtin_amdgcn_fence(__ATOMIC_ACQUIRE, "agent");
            asm volatile("s_waitcnt vmcnt(0)" ::: "memory");
        }
    }
    __syncthreads();
}

constexpr int RING_OFF = 0, RING_BYTES = 131072;
constexpr int RS_OFF = RING_BYTES;
constexpr int MISC_OFF = RS_OFF + 2048;
constexpr int LDS_BYTES = 147456;
constexpr int NWAVES = 8;
constexpr int CW_BAR = 1024;
static_assert(MISC_OFF + 128 <= LDS_BYTES && (CW_BAR + 4 * XCD_BAR_WORDS) * 4 <= (int)CTL_ZERO_BYTES, "maps");

struct Frame {
    LAS unsigned char* lds;
    volatile LAS unsigned* MISC;
    int tid, lane, wave, vcu, G;
};

__device__ __forceinline__ void transpose_item(const float* __restrict__ W, int ldw, int k0, int n0, bf16* WT, int ldt, int drow0, LAS float* scr, int lane) {
#pragma unroll 8
    for (int i = 0; i < 32; ++i) { const int kk = 2 * i + (lane >> 5); scr[kk * 33 + (lane & 31)] = W[(size_t)(k0 + kk) * ldw + n0 + (lane & 31)]; }
    LDS_WAIT(); asm volatile("" ::: "memory");
    const int c = lane & 7;
#pragma unroll
    for (int j = 0; j < 4; ++j) { const int n = (lane >> 3) + 8 * j; const LAS float* s = scr + (8 * c) * 33 + n;
        v4u o; o.x = pk2(s[0 * 33], s[1 * 33]); o.y = pk2(s[2 * 33], s[3 * 33]); o.z = pk2(s[4 * 33], s[5 * 33]); o.w = pk2(s[6 * 33], s[7 * 33]);
        *(GAS v4u*)(WT + (size_t)(drow0 + n) * ldt + k0 + 8 * c) = o; }
    LDS_WAIT(); asm volatile("" ::: "memory");
}
__device__ __forceinline__ int gu_row(int j) { return j < DFF ? (j >> 7) * 256 + (j & 127) : ((j - DFF) >> 7) * 256 + 128 + ((j - DFF) & 127); }

__device__ __forceinline__ void gemv4_cols32(Frame& F, const LAS float* vec, const float* __restrict__ W, int ldw, int col0, int ncols, LAS float* red) {
    const int rsub = F.lane >> 3, ch = F.lane & 7;
    float acc[4][4];
#pragma unroll
    for (int b = 0; b < 4; ++b)
#pragma unroll
        for (int e = 0; e < 4; ++e) acc[b][e] = 0.f;
    const bool on = 4 * ch < ncols;
    const float* wp = W + (size_t)(F.wave * 128 + rsub) * ldw + col0 + 4 * ch;
#pragma unroll 4
    for (int it = 0; it < 16; ++it) {
        const int k = F.wave * 128 + it * 8 + rsub;
        f32x4 wv = {0.f, 0.f, 0.f, 0.f};
        if (on) wv = *(const f32x4*)(wp + (size_t)it * 8 * ldw);
#pragma unroll
        for (int b = 0; b < 4; ++b) { const float c = vec[b * 1024 + k];
#pragma unroll
            for (int e = 0; e < 4; ++e) acc[b][e] += c * wv[e]; }
    }
#pragma unroll
    for (int b = 0; b < 4; ++b)
#pragma unroll
        for (int e = 0; e < 4; ++e) { float v = acc[b][e]; v += __shfl_xor(v, 8); v += __shfl_xor(v, 16); v += __shfl_xor(v, 32); if (rsub == 0) red[(F.wave * 8 + ch) * 16 + b * 4 + e] = v; }
    __syncthreads();
    if (F.tid < 128) { const int b = F.tid >> 5, col = F.tid & 31; float s = 0.f;
#pragma unroll
        for (int w = 0; w < 8; ++w) s += red[(w * 8 + (col >> 2)) * 16 + b * 4 + (col & 3)];
        red[1024 + F.tid] = s; }
    __syncthreads();
}

struct Args { const float* in[20]; float* out; unsigned char* ws; int ph_lo, ph_hi, li, pad; };

__device__ __forceinline__ void p0_prologue(Frame& F, const Args& a) {
    unsigned char* ws = a.ws;
    const int c = F.vcu;
    if (c < 192) {
        LAS float* vec = (LAS float*)(F.lds + RING_OFF); LAS float* red = (LAS float*)(F.lds + RING_OFF + 16384);
        for (int i = F.tid; i < 4096; i += NWAVES * 64) vec[i] = silu_f(a.in[1][i]);
        __syncthreads();
        gemv4_cols32(F, vec, a.in[2], 6144, 32 * c, 32, red);
        if (F.tid < 128) { const int b = F.tid >> 5, col = 32 * c + (F.tid & 31); ((float*)(ws + WS_MOD))[b * 6144 + col] = red[1024 + F.tid] + a.in[3][col]; }
        __syncthreads();
    }
    LAS float* scr = (LAS float*)(F.lds + RING_OFF + 32768 + F.wave * 8704);
    const int gw = c * NWAVES + F.wave, NGW = F.G * NWAVES;
    constexpr int I_IN = 16 * 72, I_O = 16 * 32, I_GU = 16 * 176, I_DN = 44 * 32, NITEMS = I_IN + I_O + I_GU + I_DN;
    for (int it = gw; it < NITEMS; it += NGW) {
        int r = it;
        if (r < I_IN) { const int kb = r / 72, nb = r % 72; transpose_item(a.in[5], NIN, 64 * kb, 32 * nb, (bf16*)(ws + WS_W1T), D, 32 * nb, scr, F.lane); continue; } r -= I_IN;
        if (r < I_O) { const int kb = r / 32, nb = r % 32; transpose_item(a.in[14], D, 64 * kb, 32 * nb, (bf16*)(ws + WS_WOT), D, 32 * nb, scr, F.lane); continue; } r -= I_O;
        if (r < I_GU) { const int kb = r / 176, nb = r % 176; transpose_item(a.in[16], NGU, 64 * kb, 32 * nb, (bf16*)(ws + WS_WGUT), D, gu_row(32 * nb), scr, F.lane); continue; } r -= I_GU;
        { const int kb = r / 32, nb = r % 32; transpose_item(a.in[17], D, 64 * kb, 32 * nb, (bf16*)(ws + WS_WDT), DFF, 32 * nb, scr, F.lane); }
    }
    if (gw < 16) { const int k = 64 * gw + F.lane; const float* wp = a.in[5] + (size_t)k * NIN + ODT; bf16* o = (bf16*)(ws + WS_W1T);
#pragma unroll
        for (int n = 0; n < 8; ++n) o[(size_t)(ODT + n) * D + k] = (bf16)f2bf(wp[n]); }
    { GAS v4u* z = (GAS v4u*)(ws + WS_W1T + (size_t)NIN * D * 2); const int nz = (NINP - NIN) * D * 2 / 16; const v4u zero = {0u, 0u, 0u, 0u};
        for (int i = gw * 64 + F.lane; i < nz; i += NGW * 64) z[i] = zero; }
}

__device__ __forceinline__ void p0b_rows(Frame& F, const Args& a) {
    unsigned char* ws = a.ws;
    const float* MOD = (const float*)(ws + WS_MOD);
    const int c = F.vcu;
    if (c < 249) {
        LAS float* vec = (LAS float*)(F.lds + RING_OFF); LAS float* red = (LAS float*)(F.lds + RING_OFF + 16384);
        const bool first = c < 73; const int soff = first ? 0 : 3072;
        for (int i = F.tid; i < 4096; i += NWAVES * 64) vec[i] = MOD[(i >> 10) * 6144 + soff + (i & 1023)];
        __syncthreads();
        if (first) {
            const int col0 = 32 * c, nc = (NIN - col0) < 32 ? (NIN - col0) : 32;
            gemv4_cols32(F, vec, a.in[5], NIN, col0, nc, red);
            if (F.tid < 128) { const int b = F.tid >> 5, j = F.tid & 31; ((float*)(ws + WS_BIAS1))[b * NINP + col0 + j] = (j < nc) ? red[1024 + F.tid] : 0.f; }
        } else {
            const int col0 = 32 * (c - 73);
            gemv4_cols32(F, vec, a.in[16], NGU, col0, 32, red);
            if (F.tid < 128) { const int b = F.tid >> 5, j = F.tid & 31; ((float*)(ws + WS_BIAS2))[b * NGU + gu_row(col0 + j)] = red[1024 + F.tid]; }
        }
        __syncthreads();
    } else if (c == 255) {
        for (int i = F.tid; i < 4 * (NINP - 2336); i += NWAVES * 64) { const int b = i / (NINP - 2336), j = i % (NINP - 2336); ((float*)(ws + WS_BIAS1))[b * NINP + 2336 + j] = 0.f; }
        for (int i = F.tid; i < 4096; i += NWAVES * 64) { const int b = i >> 10, k = i & 1023; ((float*)(ws + WS_GM2))[i] = a.in[15][k] * (1.f + MOD[b * 6144 + 4096 + k]); }
    }
    const int gw = c * NWAVES + F.wave;
    const int b = gw >> 9;
    f32x4 gm[4];
#pragma unroll
    for (int j = 0; j < 4; ++j) { const f32x4 g = *(const f32x4*)(a.in[4] + 4 * F.lane + 256 * j), s = *(const f32x4*)(MOD + b * 6144 + 1024 + 4 * F.lane + 256 * j); gm[j] = g * (1.f + s); }
    bf16* A1 = (bf16*)(ws + WS_A); float* RSTD = (float*)(ws + WS_RSTD1);
#pragma unroll 2
    for (int rr = 0; rr < 16; ++rr) {
        const size_t row = (size_t)gw * 16 + rr;
        const GAS f32x4* xr = (const GAS f32x4*)(a.in[0] + row * D) + F.lane;
        f32x4 v[4]; float s = 0.f;
#pragma unroll
        for (int j = 0; j < 4; ++j) { v[j] = xr[64 * j]; s += (v[j].x * v[j].x + v[j].y * v[j].y) + (v[j].z * v[j].z + v[j].w * v[j].w); }
        const float tot = wave_sum(s);
        if (F.lane == 0) RSTD[row] = rsqrtf(tot * (1.f / D) + EPS);
        GAS unsigned long long* o8 = (GAS unsigned long long*)(A1 + row * D) + F.lane;
#pragma unroll
        for (int j = 0; j < 4; ++j) { const f32x4 o = v[j] * gm[j]; o8[64 * j] = (unsigned long long)pk2(o.x, o.y) | ((unsigned long long)pk2(o.z, o.w) << 32); }
    }
}

__device__ __forceinline__ void p6_final(Frame& F, const Args& a) {
    const int gw = F.vcu * NWAVES + F.wave;
    f32x4 gf[4];
#pragma unroll
    for (int j = 0; j < 4; ++j) gf[j] = *(const f32x4*)(a.in[19] + 4 * F.lane + 256 * j);
#pragma unroll 2
    for (int rr = 0; rr < 16; ++rr) {
        const size_t row = (size_t)gw * 16 + rr;
        GAS f32x4* xr = (GAS f32x4*)(a.out + row * D) + F.lane;
        f32x4 v[4]; float s = 0.f;
#pragma unroll
        for (int j = 0; j < 4; ++j) { v[j] = xr[64 * j]; s += (v[j].x * v[j].x + v[j].y * v[j].y) + (v[j].z * v[j].z + v[j].w * v[j].w); }
        const float rstd = rsqrtf(wave_sum(s) * (1.f / D) + EPS);
#pragma unroll
        for (int j = 0; j < 4; ++j) xr[64 * j] = v[j] * rstd * gf[j];
    }
}

__global__ void __launch_bounds__(NWAVES * 64, 2) mk_fwd(Args args) {
    extern __shared__ __attribute__((aligned(16))) unsigned char lds[];
    Frame F;
    F.lds = (LAS unsigned char*)lds;
    F.MISC = (volatile LAS unsigned*)(F.lds + MISC_OFF);
    F.tid = threadIdx.x; F.lane = F.tid & 63; F.wave = __builtin_amdgcn_readfirstlane(F.tid >> 6);
    F.G = gridDim.x; { const int bx = blockIdx.x; F.vcu = (bx % 8) * (F.G / 8) + bx / 8; }
    unsigned char* ws = args.ws;
    gu32* ctl = (gu32*)(ws + WS_CTL);
    for (int u = F.tid; u < (LDS_BYTES - MISC_OFF) / 4; u += NWAVES * 64) ((LAS unsigned*)(F.lds + MISC_OFF))[u] = 0u;
    __syncthreads();
    XcdBarrier bar = xcd_barrier_post((unsigned*)(ctl + CW_BAR) + args.li * XCD_BAR_WORDS, F.MISC + 8);
    const int lo = args.ph_lo, hi = args.ph_hi;
#define IN(k) (lo <= (k) && (k) < hi)
#define BOTH(k) (IN(k) && IN((k) + 1))
#define GRID_BAR() xcd_barrier(bar)
    LAS float* rs = (LAS float*)(F.lds + RS_OFF);
    const int pA = 2 * (F.vcu >> 2);

    if (IN(0)) { p0_prologue(F, args); if (BOTH(0)) GRID_BAR(); }
    if (IN(1)) { p0b_rows(F, args); if (BOTH(1)) GRID_BAR(); }
    if (IN(2)) {
        rs[F.tid] = ((const float*)(ws + WS_RSTD1))[pA * 256 + F.tid];
        __syncthreads();
        pg8::Gemm g{(const bf16*)(ws + WS_A), (const bf16*)(ws + WS_W1T), T, NINP, D}; pg8::QuadOrder S; S.init(NINP, F.vcu);
        pg8::EpiIn E{(bf16*)(ws + WS_PROJ), (const float*)(ws + WS_BIAS1), (float*)(ws + WS_DT), rs};
        pg8::gemm_phase<pg8::EpiIn, pg8::QuadOrder, true, true>(F.lds + RING_OFF, g, S, E);
        if (BOTH(2)) GRID_BAR();
    }
    if (IN(4)) {
        pg8::Gemm g{(const bf16*)(ws + WS_YMIX), (const bf16*)(ws + WS_WOT), T, D, D}; pg8::QuadOrder S; S.init(D, F.vcu);
        pg8::EpiWo E{args.in[0], args.out, (bf16*)(ws + WS_A), (float*)(ws + WS_SS2), (const float*)(ws + WS_MOD) + 2048, (const float*)(ws + WS_GM2)};
        pg8::gemm_phase<pg8::EpiWo, pg8::QuadOrder, true, true>(F.lds + RING_OFF, g, S, E);
        if (BOTH(4)) GRID_BAR();
    }
    if (IN(5)) {
        { const f32x4* p = (const f32x4*)((const float*)(ws + WS_SS2) + (size_t)(pA * 256 + F.tid) * 16); const f32x4 s0 = p[0], s1 = p[1], s2 = p[2], s3 = p[3];
          const f32x4 t = (s0 + s1) + (s2 + s3); rs[F.tid] = rsqrtf(((t[0] + t[1]) + (t[2] + t[3])) * (1.f / D) + EPS); }
        __syncthreads();
        pg8::Gemm g{(const bf16*)(ws + WS_A), (const bf16*)(ws + WS_WGUT), T, NGU, D}; pg8::QuadOrder S; S.init(NGU, F.vcu);
        pg8::EpiGU E{(bf16*)(ws + WS_ACT), (const float*)(ws + WS_BIAS2), rs};
        pg8::gemm_phase<pg8::EpiGU, pg8::QuadOrder, true, true>(F.lds + RING_OFF, g, S, E);
        if (BOTH(5)) GRID_BAR();
    }
    if (IN(6)) {
        pg8::Gemm g{(const bf16*)(ws + WS_ACT), (const bf16*)(ws + WS_WDT), T, D, DFF}; pg8::QuadOrder S; S.init(D, F.vcu);
        pg8::EpiDown E{args.out, (const float*)(ws + WS_MOD) + 5120};
        pg8::gemm_phase<pg8::EpiDown, pg8::QuadOrder, true, true>(F.lds + RING_OFF, g, S, E);
        if (BOTH(6)) GRID_BAR();
    }
    if (IN(7)) p6_final(F, args);
#undef IN
#undef BOTH
#undef GRID_BAR
}

extern "C" void kernel_launch(void* const* d_in, const int* in_sizes, int n_in, void* d_out, int out_size, void* d_ws, size_t ws_size, hipStream_t stream) {
    static int grid = 0;
    if (grid == 0) {
        if (n_in != 20 || in_sizes[0] != T * D || out_size != T * D || ws_size < WS_END) { fprintf(stderr, "kernel_launch: unexpected shapes (n_in %d, ws %zu)\n", n_in, ws_size); grid = -1; return; }
        int dev = 0, cus = 0;
        if (hipGetDevice(&dev) != hipSuccess || hipDeviceGetAttribute(&cus, hipDeviceAttributeMultiprocessorCount, dev) != hipSuccess) { grid = -1; return; }
        if (hipFuncSetAttribute((const void*)mk_fwd, hipFuncAttributeMaxDynamicSharedMemorySize, LDS_BYTES) != hipSuccess) { fprintf(stderr, "kernel_launch: hipFuncSetAttribute failed\n"); grid = -1; return; }
        grid = cus;
        if (grid != 256) fprintf(stderr, "kernel_launch: %d CUs; this kernel is laid out for 256\n", grid);
    }
    if (grid < 0) return;
    (void)hipMemsetAsync((char*)d_ws + WS_CTL, 0, CTL_ZERO_BYTES, stream);
    Args a{};
    for (int i = 0; i < 20; ++i) a.in[i] = (const float*)d_in[i];
    a.out = (float*)d_out; a.ws = (unsigned char*)d_ws;
    unsigned char* ws = (unsigned char*)d_ws;
    a.ph_lo = 0; a.ph_hi = 3; a.li = 0;
    hipLaunchKernelGGL(mk_fwd, dim3(grid), dim3(NWAVES * 64), LDS_BYTES, stream, a);
    {
        const bf16* PROJ = (const bf16*)(ws + WS_PROJ); float* YF = (float*)(ws + WS_SSD); float* XC = (float*)d_out;
        k_attn<<<T * 8, 128, 0, stream>>>(PROJ, a.in[11], a.in[18], YF);
        k_conv<<<T, 256, 0, stream>>>(PROJ, a.in[6], a.in[7], XC);
        k_ssd_seq<<<BATCH * 8 * 64, 64, 0, stream>>>((const float*)(ws + WS_DT), XC, a.in[8], a.in[9], a.in[10], YF);
        k_mixnorm<<<T, 256, 0, stream>>>(PROJ, a.in[12], a.in[13], YF, (bf16*)(ws + WS_YMIX));
    }
    a.ph_lo = 4; a.ph_hi = 8; a.li = 1;
    hipLaunchKernelGGL(mk_fwd, dim3(grid), dim3(NWAVES * 64), LDS_BYTES, stream, a);
}
```

```cpp
#include <hip/hip_runtime.h>
#include <cstdio>
#include <cstdint>

constexpr int BATCH = 4, SEQ = 8192, D = 1024, T = BATCH * SEQ;
constexpr int NIN = 2312, NINP = 2560, DFF = 2816, NGU = 2 * DFF;
constexpr int OQ = 0, OK_ = 512, OV = 640, OZ = 768, OXBC = 1280, ODT = 2304;
constexpr float EPS = 1e-6f;
constexpr float LOG2E = 1.4426950408889634f;
constexpr float C2 = 0.125f * LOG2E;

__device__ const int T5B[128] = {0,1,2,3,4,5,6,7,8,9,10,11,12,13,14,15,16,16,16,17,17,18,18,18,19,19,19,20,20,20,20,21,21,21,21,22,22,22,22,22,23,23,23,23,23,23,24,24,24,24,24,24,25,25,25,25,25,25,25,26,26,26,26,26,26,26,26,27,27,27,27,27,27,27,27,27,27,28,28,28,28,28,28,28,28,28,28,29,29,29,29,29,29,29,29,29,29,29,29,30,30,30,30,30,30,30,30,30,30,30,30,30,30,31,31,31,31,31,31,31,31,31,31,31,31,31,31,31};

typedef unsigned short bf16;
__device__ __forceinline__ float bf2f(bf16 v) { return __uint_as_float((unsigned)v << 16); }
__device__ __forceinline__ unsigned f2bf(float f) { unsigned u = __builtin_bit_cast(unsigned, f); return (u + 0x7fffu + ((u >> 16) & 1u)) >> 16; }
__device__ __forceinline__ unsigned pk2(float lo, float hi) { return f2bf(lo) | (f2bf(hi) << 16); }
__device__ __forceinline__ float silu_f(float v) { return v / (1.f + __expf(-v)); }
__device__ __forceinline__ float softplus_f(float v) { return fmaxf(v, 0.f) + log1pf(expf(-fabsf(v))); }
__device__ __forceinline__ float wave_sum(float v) {
#pragma unroll
    for (int o = 1; o < 64; o <<= 1) v += __shfl_xor(v, o);
    return v;
}

constexpr size_t MiB = 1u << 20;
constexpr size_t WS_CTL = 0, CTL_ZERO_BYTES = 64 * 1024;
constexpr size_t WS_MOD = 1 * MiB;
constexpr size_t WS_BIAS1 = WS_MOD + 128 * 1024;
constexpr size_t WS_BIAS2 = WS_BIAS1 + 64 * 1024;
constexpr size_t WS_GM2 = WS_BIAS2 + 128 * 1024;
constexpr size_t WS_RSTD1 = WS_GM2 + 64 * 1024;
constexpr size_t WS_DT = 2 * MiB;
constexpr size_t WS_SS2 = 3 * MiB;
constexpr size_t WS_W1T = 6 * MiB;
constexpr size_t WS_WOT = 12 * MiB;
constexpr size_t WS_WGUT = 14 * MiB;
constexpr size_t WS_WDT = 26 * MiB;
constexpr size_t WS_A = 32 * MiB;
constexpr size_t WS_PROJ = 96 * MiB;
constexpr size_t WS_ACT = 96 * MiB;
constexpr size_t WS_YMIX = 272 * MiB;
constexpr size_t WS_SSD = 336 * MiB;
constexpr size_t WS_END = 512 * MiB;
__global__ void __launch_bounds__(128) k_attn(const bf16* __restrict__ proj, const float* __restrict__ sinks, const float* __restrict__ rel_bias, float* __restrict__ yf) {
    __shared__ float qs[64];
    __shared__ float ps[128];
    __shared__ float red[2];
    __shared__ float osum[2][64];
    const int t = blockIdx.x >> 3, h = blockIdx.x & 7, kvh = h >> 2, s = t % SEQ, tid = threadIdx.x;
    if (tid < 64) qs[tid] = bf2f(proj[(size_t)t * NINP + OQ + h * 64 + tid]) * (1.f / LOG2E);
    __syncthreads();
    const int kp = s - tid;
    const bool valid = kp >= 0;
    float sc = -INFINITY;
    if (valid) {
        const bf16* kr = proj + (size_t)(t - tid) * NINP + OK_ + kvh * 64;
        float a = 0.f;
#pragma unroll 8
        for (int d = 0; d < 64; ++d) a += qs[d] * bf2f(kr[d]);
        sc = a + rel_bias[T5B[tid] * 8 + h];
    }
    float m = sc;
#pragma unroll
    for (int o = 1; o < 64; o <<= 1) m = fmaxf(m, __shfl_xor(m, o));
    if ((tid & 63) == 0) red[tid >> 6] = m;
    __syncthreads();
    const float sink = sinks[h];
    m = fmaxf(fmaxf(red[0], red[1]), sink);
    const float p = valid ? expf(sc - m) : 0.f;
    ps[tid] = p;
    float l = wave_sum(p);
    __syncthreads();
    if ((tid & 63) == 0) red[tid >> 6] = l;
    __syncthreads();
    const float denom = red[0] + red[1] + expf(sink - m);
    const int d = tid & 63, half = tid >> 6;
    float o = 0.f;
    for (int i = half * 64; i < half * 64 + 64; ++i) {
        if (s - i >= 0) o += ps[i] * bf2f(proj[(size_t)(t - i) * NINP + OV + kvh * 64 + d]);
    }
    osum[half][d] = o;
    __syncthreads();
    if (tid < 64) yf[(size_t)t * D + h * 64 + tid] = (osum[0][tid] + osum[1][tid]) / denom;
}

__global__ void __launch_bounds__(256) k_conv(const bf16* __restrict__ proj, const float* __restrict__ cw, const float* __restrict__ cb, float* __restrict__ xc) {
    const int t = blockIdx.x, s = t % SEQ;
    for (int c = threadIdx.x; c < 1024; c += 256) {
        float a = cb[c];
#pragma unroll
        for (int j = 0; j < 4; ++j) { const int sp = s - 3 + j; if (sp >= 0) a += cw[j * 1024 + c] * bf2f(proj[(size_t)(t - 3 + j) * NINP + OXBC + c]); }
        xc[(size_t)t * 1024 + c] = a / (1.f + expf(-a));
    }
}

__global__ void __launch_bounds__(64) k_ssd_seq(const float* __restrict__ dtraw, const float* __restrict__ xc, const float* __restrict__ dt_bias, const float* __restrict__ A_log, const float* __restrict__ D_skip, float* __restrict__ yf) {
    const int p = blockIdx.x & 63, hd = (blockIdx.x >> 6) & 7, b = blockIdx.x >> 9, g = hd >> 2, lane = threadIdx.x;
    const float A = -expf(A_log[hd]), Dk = D_skip[hd], dtb = dt_bias[hd];
    float h0 = 0.f, h1 = 0.f;
    for (int s0 = 0; s0 < SEQ; s0 += 8) {
        float dtr[8], xv[8], B0[8], B1[8], C0[8], C1[8];
#pragma unroll
        for (int u = 0; u < 8; ++u) {
            const size_t row = (size_t)b * SEQ + s0 + u;
            dtr[u] = dtraw[row * 8 + hd];
            xv[u] = xc[row * 1024 + hd * 64 + p];
            B0[u] = xc[row * 1024 + 512 + g * 128 + lane]; B1[u] = xc[row * 1024 + 512 + g * 128 + 64 + lane];
            C0[u] = xc[row * 1024 + 768 + g * 128 + lane]; C1[u] = xc[row * 1024 + 768 + g * 128 + 64 + lane];
        }
#pragma unroll
        for (int u = 0; u < 8; ++u) {
            const float dt = softplus_f(dtr[u] + dtb);
            const float dec = expf(dt * A), xd = xv[u] * dt;
            h0 = h0 * dec + xd * B0[u]; h1 = h1 * dec + xd * B1[u];
            const float y = wave_sum(C0[u] * h0 + C1[u] * h1);
            if (lane == 0) yf[((size_t)b * SEQ + s0 + u) * D + 512 + hd * 64 + p] = y + Dk * xv[u];
        }
    }
}

__global__ void __launch_bounds__(256) k_mixnorm(const bf16* __restrict__ proj, const float* __restrict__ ga, const float* __restrict__ gs, const float* __restrict__ yf, bf16* __restrict__ ymix, int ssm_only) {
    __shared__ float red[4];
    const int t = blockIdx.x, tid = threadIdx.x, w = tid >> 6;
    float4 v = ((const float4*)(yf + (size_t)t * D))[tid];
    if (w >= 2) {
        const bf16* zp = proj + (size_t)t * NINP + OZ + (tid - 128) * 4;
        v.x *= silu_f(bf2f(zp[0])); v.y *= silu_f(bf2f(zp[1])); v.z *= silu_f(bf2f(zp[2])); v.w *= silu_f(bf2f(zp[3]));
    }
    float s = wave_sum(v.x * v.x + v.y * v.y + v.z * v.z + v.w * v.w);
    if ((tid & 63) == 0) red[w] = s;
    __syncthreads();
    float rstd; float4 gv;
    if (w < 2) { rstd = rsqrtf((red[0] + red[1]) * (1.f / 512.f) + EPS); gv = ((const float4*)ga)[tid]; }
    else { rstd = rsqrtf(red[w] * (1.f / 256.f) + EPS); gv = ((const float4*)gs)[tid - 128]; }
    uint2 o; o.x = pk2(v.x * rstd * gv.x, v.y * rstd * gv.y); o.y = pk2(v.z * rstd * gv.z, v.w * rstd * gv.w);
    if (!ssm_only || w >= 2) *(uint2*)(ymix + (size_t)t * D + tid * 4) = o;
}
namespace pg8 {
#define PG8_LAS __attribute__((address_space(3)))
typedef unsigned short bf16_t;
typedef short bf16x8 __attribute__((ext_vector_type(8)));
typedef float f32x4 __attribute__((ext_vector_type(4)));
typedef unsigned u32x4 __attribute__((ext_vector_type(4)));
constexpr int BM = 256, BK = 64, HALF = 128, HTB = HALF * BK * 2  , STAGE_BYTES = 8 * HTB, NXCD = 8, WGM = 8;

__host__ __device__ __forceinline__ int lds_byte(int r, int c) { const int st = (r >> 4) * 2 + (c >> 5), rr = r & 15, cc = c & 31, ob = rr * 64 + cc * 2; return st * 1024 + (ob ^ (((ob >> 9) & 1) << 5)); }
__host__ __device__ __forceinline__ void stage_rc(int b, int& R, int& C) { const int st = b / 1024, sb = b % 1024, swz = sb ^ (((sb >> 9) & 1) << 5); R = (st >> 1) * 16 + swz / 64; C = (st & 1) * 32 + (swz % 64) / 2; }
__host__ __device__ __forceinline__ int perm32(int rho) { const int n = rho >> 4, i = rho & 15; return 8 * (i >> 2) + 4 * n + (i & 3); }

struct Unit { int pm, pn; };
struct Gemm { const bf16_t* A; const bf16_t* Bt; int M, N, K; };
__device__ __forceinline__ unsigned cvt_pk_bf16(float lo, float hi) { unsigned r; asm volatile("v_cvt_pk_bf16_f32 %0, %1, %2" : "=v"(r) : "v"(lo), "v"(hi)); return r; }
typedef float f32x2 __attribute__((ext_vector_type(2)));

struct QuadOrder {
    int pA, cntA, startA, cntB, startB;
    __device__ __forceinline__ void init(int N, int vcu) {
        const int nN = N / BM, q = vcu >> 2, j = vcu & 3, base = nN / 4, rem = nN % 4;
        pA = 2 * q;
        cntA = base + (j < rem ? 1 : 0); startA = j * base + (j < rem ? j : rem);
        cntB = base + (j >= 4 - rem ? 1 : 0); startB = j * base + (j > 4 - rem ? j - (4 - rem) : 0);
    }
    __device__ __forceinline__ bool next(int i, Unit& u) const {
        if (i < cntA) { u.pm = pA; u.pn = startA + i; return true; }
        i -= cntA;
        if (i < cntB) { u.pm = pA + 1; u.pn = startB + i; return true; }
        return false;
    }
    __device__ __forceinline__ void a_ready(const Unit&) const {}
    __device__ __forceinline__ void done(const Unit&) const {}
};


struct EpiIn {
    static constexpr bool PERM = true, AFTER_DRAIN = false;
    bf16_t* O; const float* bias; float* DT; const PG8_LAS float* rs;
    __device__ __forceinline__ void operator()(const f32x4 (&acc)[2][2][4][2], const Unit& u, int wr, int wc, int fr, int fq) const {
        const int slot = u.pm & 1, b = u.pm >> 5, rl0 = wr * 64 + fr, colb = u.pn * BM + wc * 32 + 8 * fq;
        const float sc = (u.pn < 2) ? C2 : 1.f;
        f32x4 bv[2][2];
#pragma unroll
        for (int bj = 0; bj < 2; ++bj)
#pragma unroll
            for (int n = 0; n < 2; ++n) bv[bj][n] = *(const f32x4*)(bias + b * NINP + colb + bj * HALF + 4 * n);
#pragma unroll
        for (int ai = 0; ai < 2; ++ai)
#pragma unroll
            for (int m = 0; m < 4; ++m) {
                const int rl = ai * HALF + rl0 + m * 16; const float rstd = rs[slot * 256 + rl]; const size_t r = (size_t)u.pm * BM + rl;
#pragma unroll
                for (int bj = 0; bj < 2; ++bj) {
                    const f32x4 v0 = (acc[ai][bj][m][0] * rstd + bv[bj][0]) * sc, v1 = (acc[ai][bj][m][1] * rstd + bv[bj][1]) * sc;
                    u32x4 w; w.x = cvt_pk_bf16(v0[0], v0[1]); w.y = cvt_pk_bf16(v0[2], v0[3]); w.z = cvt_pk_bf16(v1[0], v1[1]); w.w = cvt_pk_bf16(v1[2], v1[3]);
                    *(u32x4*)(O + r * NINP + colb + bj * HALF) = w;
                    if (bj == 0 && u.pn == 9 && wc == 0 && fq == 0) { *(f32x4*)(DT + r * 8) = v0; *(f32x4*)(DT + r * 8 + 4) = v1; }
                }
            }
    }
};

struct EpiWo {
    static constexpr bool PERM = true, AFTER_DRAIN = false;
    const float* x; float* x1; bf16_t* A2; float* ss; const float* gate; const float* gm2;
    __device__ __forceinline__ void operator()(const f32x4 (&acc)[2][2][4][2], const Unit& u, int wr, int wc, int fr, int fq) const {
        const int b = u.pm >> 5, rl0 = wr * 64 + fr, colb = u.pn * BM + wc * 32 + 8 * fq;
        f32x4 gv[2][2], mv[2][2];
#pragma unroll
        for (int bj = 0; bj < 2; ++bj)
#pragma unroll
            for (int n = 0; n < 2; ++n) { gv[bj][n] = *(const f32x4*)(gate + b * 6144 + colb + bj * HALF + 4 * n); mv[bj][n] = *(const f32x4*)(gm2 + b * 1024 + colb + bj * HALF + 4 * n); }
#pragma unroll
        for (int ai = 0; ai < 2; ++ai)
#pragma unroll
            for (int m = 0; m < 4; ++m) {
                const int rl = ai * HALF + rl0 + m * 16; const size_t r = (size_t)u.pm * BM + rl; float q = 0.f;
#pragma unroll
                for (int bj = 0; bj < 2; ++bj) {
                    const size_t off = r * 1024 + colb + bj * HALF;
                    const f32x4 xa = *(const f32x4*)(x + off), xb = *(const f32x4*)(x + off + 4);
                    const f32x4 o0 = xa + gv[bj][0] * acc[ai][bj][m][0], o1 = xb + gv[bj][1] * acc[ai][bj][m][1];
                    *(f32x4*)(x1 + off) = o0; *(f32x4*)(x1 + off + 4) = o1;
                    q += (o0[0] * o0[0] + o0[1] * o0[1]) + (o0[2] * o0[2] + o0[3] * o0[3]) + (o1[0] * o1[0] + o1[1] * o1[1]) + (o1[2] * o1[2] + o1[3] * o1[3]);
                    const f32x4 a0 = o0 * mv[bj][0], a1 = o1 * mv[bj][1];
                    u32x4 w; w.x = cvt_pk_bf16(a0[0], a0[1]); w.y = cvt_pk_bf16(a0[2], a0[3]); w.z = cvt_pk_bf16(a1[0], a1[1]); w.w = cvt_pk_bf16(a1[2], a1[3]);
                    *(u32x4*)(A2 + off) = w;
                }
                q += __shfl_xor(q, 16); q += __shfl_xor(q, 32);
                if (fq == 0) ss[r * 16 + u.pn * 4 + wc] = q;
            }
    }
};

struct EpiGU {
    static constexpr bool PERM = true, AFTER_DRAIN = false;
    bf16_t* ACT; const float* bias; const PG8_LAS float* rs;
    __device__ __forceinline__ void operator()(const f32x4 (&acc)[2][2][4][2], const Unit& u, int wr, int wc, int fr, int fq) const {
        const int slot = u.pm & 1, b = u.pm >> 5, rl0 = wr * 64 + fr, colb = u.pn * BM + wc * 32 + 8 * fq, ocol = u.pn * HALF + wc * 32 + 8 * fq;
        f32x4 bv[2][2];
#pragma unroll
        for (int bj = 0; bj < 2; ++bj)
#pragma unroll
            for (int n = 0; n < 2; ++n) bv[bj][n] = *(const f32x4*)(bias + b * NGU + colb + bj * HALF + 4 * n);
#pragma unroll
        for (int ai = 0; ai < 2; ++ai)
#pragma unroll
            for (int m = 0; m < 4; ++m) {
                const int rl = ai * HALF + rl0 + m * 16; const float rstd = rs[slot * 256 + rl]; const size_t r = (size_t)u.pm * BM + rl;
                float a[8];
#pragma unroll
                for (int n = 0; n < 2; ++n) {
                    const f32x4 g = acc[ai][0][m][n] * rstd + bv[0][n], uu = acc[ai][1][m][n] * rstd + bv[1][n];
#pragma unroll
                    for (int e = 0; e < 4; ++e) a[4 * n + e] = g[e] * __builtin_amdgcn_rcpf(1.f + __builtin_amdgcn_exp2f(-LOG2E * g[e])) * uu[e];
                }
                u32x4 w; w.x = cvt_pk_bf16(a[0], a[1]); w.y = cvt_pk_bf16(a[2], a[3]); w.z = cvt_pk_bf16(a[4], a[5]); w.w = cvt_pk_bf16(a[6], a[7]);
                *(u32x4*)(ACT + r * DFF + ocol) = w;
            }
    }
};

struct EpiDown {
    static constexpr bool PERM = true, AFTER_DRAIN = false;
    float* xio; const float* gate;
    __device__ __forceinline__ void operator()(const f32x4 (&acc)[2][2][4][2], const Unit& u, int wr, int wc, int fr, int fq) const {
        const int b = u.pm >> 5, rl0 = wr * 64 + fr, colb = u.pn * BM + wc * 32 + 8 * fq;
        f32x4 gv[2][2];
#pragma unroll
        for (int bj = 0; bj < 2; ++bj)
#pragma unroll
            for (int n = 0; n < 2; ++n) gv[bj][n] = *(const f32x4*)(gate + b * 6144 + colb + bj * HALF + 4 * n);
#pragma unroll
        for (int ai = 0; ai < 2; ++ai)
#pragma unroll
            for (int m = 0; m < 4; ++m) {
                const int rl = ai * HALF + rl0 + m * 16; const size_t r = (size_t)u.pm * BM + rl;
#pragma unroll
                for (int bj = 0; bj < 2; ++bj) {
                    const size_t off = r * 1024 + colb + bj * HALF;
                    const f32x4 xa = *(const f32x4*)(xio + off), xb = *(const f32x4*)(xio + off + 4);
                    *(f32x4*)(xio + off) = xa + gv[bj][0] * acc[ai][bj][m][0]; *(f32x4*)(xio + off + 4) = xb + gv[bj][1] * acc[ai][bj][m][1];
                }
            }
    }
};

template <class Epi, class Sched, bool ALIGN_EPI = false, bool SP2 = false>
__device__ __forceinline__ void gemm_phase(PG8_LAS unsigned char* lds, const Gemm g, const Sched& S, const Epi& E) {
    const int tid = threadIdx.x, wid = __builtin_amdgcn_readfirstlane(tid >> 6), lane = tid & 63, wr = wid >> 2, wc = wid & 3, fr = lane & 15, fq = lane >> 4;
    const int K = g.K, nt = K / BK;
    unsigned voffA[2], voffB[2];
#pragma unroll
    for (int i = 0; i < 2; ++i) { int R, C; stage_rc(tid * 16 + i * 8192, R, C); const int Rb = Epi::PERM ? ((R & ~31) + perm32(R & 31)) : R;
        voffA[i] = (unsigned)(R * K + C) * 2u; voffB[i] = (unsigned)(Rb * K + C) * 2u; }
    const size_t kstep = (size_t)(BK * 2);
    const size_t hstep = (size_t)HALF * K * 2;
    const size_t tstep = 2 * hstep;
    const unsigned ldsw = (unsigned)wid * 1024u;
    const int aoff = lds_byte(wr * 64 + fr, fq * 8), boff = lds_byte(wc * 32 + fr, fq * 8);
#define PG8_SA(b, h) (((b) * 2 + (h)) * HTB)
#define PG8_SB(b, h) ((4 + (b) * 2 + (h)) * HTB)
#define PG8_STAGE(bufoff, gbase, voff) do { _Pragma("unroll") for (int _i = 0; _i < 2; ++_i) \
        __builtin_amdgcn_global_load_lds((const unsigned*)((const char*)(gbase) + (voff)[_i]), (PG8_LAS unsigned*)(lds + (bufoff) + ldsw + _i * 8192), 16, 0, 0); } while (0)
#define PG8_LDA(dst, b, h) do { _Pragma("unroll") for (int m = 0; m < 4; ++m) _Pragma("unroll") for (int k = 0; k < 2; ++k) dst[m][k] = *(const PG8_LAS bf16x8*)(lds + PG8_SA(b, h) + aoff + m * 2048 + k * 1024); } while (0)
#define PG8_LDB(dst, b, h) do { _Pragma("unroll") for (int n = 0; n < 2; ++n) _Pragma("unroll") for (int k = 0; k < 2; ++k) dst[n][k] = *(const PG8_LAS bf16x8*)(lds + PG8_SB(b, h) + boff + n * 2048 + k * 1024); } while (0)
#define PG8_MMA(ai, bj, At, Bt) do { __builtin_amdgcn_s_setprio(1); _Pragma("unroll") for (int m = 0; m < 4; ++m) _Pragma("unroll") for (int n = 0; n < 2; ++n) _Pragma("unroll") for (int k = 0; k < 2; ++k) \
        acc[ai][bj][m][n] = __builtin_amdgcn_mfma_f32_16x16x32_bf16(Bt[n][k], At[m][k], acc[ai][bj][m][n], 0, 0, 0); __builtin_amdgcn_s_setprio(0); } while (0)
#define PG8_WAIT_V(n) asm volatile("s_waitcnt vmcnt(" #n ")" ::: "memory")
#define PG8_WAIT_L(n) asm volatile("s_waitcnt lgkmcnt(" #n ")" ::: "memory")
#define PG8_BAR __builtin_amdgcn_s_barrier()
#define PG8_SCHED __builtin_amdgcn_sched_barrier(0)
    Unit cur, nxt; int ui = 0;
    if (!S.next(0, cur)) return;
    f32x4 acc[2][2][4][2];
#pragma unroll
    for (int a = 0; a < 2; ++a)
#pragma unroll
        for (int b = 0; b < 2; ++b)
#pragma unroll
            for (int m = 0; m < 4; ++m)
#pragma unroll
                for (int n = 0; n < 2; ++n) acc[a][b][m][n] = (f32x4){0.f, 0.f, 0.f, 0.f};
    bf16x8 At[4][2], B0[2][2], B1[2][2];
    const char* cA = (const char*)g.A + (size_t)cur.pm * tstep; const char* cB = (const char*)g.Bt + (size_t)cur.pn * tstep;
    S.a_ready(cur);
    if constexpr (SP2) {
        PG8_STAGE(PG8_SB(0, 0), cB, voffB); PG8_STAGE(PG8_SB(0, 1), cB + hstep, voffB); PG8_STAGE(PG8_SA(0, 0), cA, voffA); PG8_STAGE(PG8_SA(0, 1), cA + hstep, voffA);
        if (wr == 1) PG8_BAR;
        PG8_WAIT_V(2); PG8_BAR;
        PG8_STAGE(PG8_SB(1, 0), cB + kstep, voffB); PG8_STAGE(PG8_SA(1, 0), cA + kstep, voffA); PG8_STAGE(PG8_SB(1, 1), cB + hstep + kstep, voffB);
        PG8_WAIT_V(6); PG8_BAR;
    } else {
        PG8_STAGE(PG8_SB(0, 0), cB, voffB); PG8_STAGE(PG8_SA(0, 0), cA, voffA); PG8_STAGE(PG8_SB(0, 1), cB + hstep, voffB); PG8_STAGE(PG8_SA(0, 1), cA + hstep, voffA);
        if (wr == 1) PG8_BAR;
        PG8_WAIT_V(4); PG8_BAR;
        PG8_STAGE(PG8_SB(1, 0), cB + kstep, voffB); PG8_STAGE(PG8_SA(1, 0), cA + kstep, voffA); PG8_STAGE(PG8_SB(1, 1), cB + hstep + kstep, voffB);
        PG8_WAIT_V(6); PG8_BAR;
    }
    for (;;) {
        const bool has_next = S.next(ui + 1, nxt);
        const char* nA = has_next ? (const char*)g.A + (size_t)nxt.pm * tstep : cA; const char* nB = has_next ? (const char*)g.Bt + (size_t)nxt.pn * tstep : cB;
        for (int t = 0; t < nt; t += 2) {
            const bool last = (t == nt - 2);
            const char* a1 = cA + (size_t)(t + 1) * kstep;
            const char* a2 = last ? nA : cA + (size_t)(t + 2) * kstep; const char* b2 = last ? nB : cB + (size_t)(t + 2) * kstep;
            const char* a3 = a2 + kstep; const char* b3 = b2 + kstep;
            if (last && has_next) S.a_ready(nxt);
            if constexpr (SP2) {
            PG8_LDB(B0, 0, 0); PG8_LDB(B1, 0, 1); PG8_SCHED; PG8_LDA(At, 0, 0); PG8_STAGE(PG8_SA(1, 1), a1 + hstep, voffA);
            PG8_WAIT_V(8); PG8_WAIT_L(0); PG8_BAR; PG8_MMA(0, 0, At, B0); PG8_MMA(0, 1, At, B1); PG8_BAR; PG8_SCHED;
            PG8_LDA(At, 0, 1); PG8_STAGE(PG8_SB(0, 0), b2, voffB); PG8_STAGE(PG8_SB(0, 1), b2 + hstep, voffB); PG8_STAGE(PG8_SA(0, 0), a2, voffA);
            PG8_WAIT_V(8); PG8_WAIT_L(0); PG8_BAR; PG8_MMA(1, 0, At, B0); PG8_MMA(1, 1, At, B1); PG8_BAR; PG8_SCHED;
            PG8_LDB(B0, 1, 0); PG8_LDB(B1, 1, 1); PG8_SCHED; PG8_LDA(At, 1, 0); PG8_STAGE(PG8_SA(0, 1), a2 + hstep, voffA);
            PG8_WAIT_V(8); PG8_WAIT_L(0); PG8_BAR; PG8_MMA(0, 0, At, B0); PG8_MMA(0, 1, At, B1); PG8_BAR; PG8_SCHED;
            PG8_LDA(At, 1, 1); PG8_STAGE(PG8_SB(1, 0), b3, voffB); PG8_STAGE(PG8_SB(1, 1), b3 + hstep, voffB); PG8_STAGE(PG8_SA(1, 0), a3, voffA);
            PG8_WAIT_V(8); PG8_WAIT_L(0); PG8_BAR; PG8_MMA(1, 0, At, B0); PG8_MMA(1, 1, At, B1); PG8_BAR; PG8_SCHED;
            } else {
            PG8_LDB(B0, 0, 0); PG8_SCHED; PG8_LDA(At, 0, 0); PG8_STAGE(PG8_SA(1, 1), a1 + hstep, voffA);
            PG8_WAIT_L(8); PG8_BAR; PG8_WAIT_L(0); PG8_MMA(0, 0, At, B0); PG8_BAR; PG8_SCHED;
            PG8_LDB(B1, 0, 1); PG8_STAGE(PG8_SB(0, 0), b2, voffB);
            PG8_BAR; PG8_WAIT_L(0); PG8_MMA(0, 1, At, B1); PG8_BAR;
            PG8_LDA(At, 0, 1); PG8_STAGE(PG8_SA(0, 0), a2, voffA);
            PG8_BAR; PG8_WAIT_L(0); PG8_MMA(1, 0, At, B0); PG8_BAR; PG8_SCHED;
            PG8_STAGE(PG8_SB(0, 1), b2 + hstep, voffB);
            PG8_WAIT_V(6); PG8_BAR; PG8_MMA(1, 1, At, B1); PG8_BAR;
            PG8_LDB(B0, 1, 0); PG8_SCHED; PG8_LDA(At, 1, 0); PG8_STAGE(PG8_SA(0, 1), a2 + hstep, voffA);
            PG8_WAIT_L(8); PG8_BAR; PG8_WAIT_L(0); PG8_MMA(0, 0, At, B0); PG8_BAR; PG8_SCHED;
            PG8_LDB(B1, 1, 1); PG8_STAGE(PG8_SB(1, 0), b3, voffB);
            PG8_BAR; PG8_WAIT_L(0); PG8_MMA(0, 1, At, B1); PG8_BAR;
            PG8_LDA(At, 1, 1); PG8_STAGE(PG8_SA(1, 0), a3, voffA);
            PG8_BAR; PG8_WAIT_L(0); PG8_MMA(1, 0, At, B0); PG8_BAR; PG8_SCHED;
            PG8_STAGE(PG8_SB(1, 1), b3 + hstep, voffB);
            PG8_WAIT_V(6); PG8_BAR; PG8_MMA(1, 1, At, B1); PG8_BAR;
            }
        }
        if constexpr (ALIGN_EPI) { if (wr == 0) PG8_BAR; }
        if constexpr (!Epi::AFTER_DRAIN) { E(acc, cur, wr, wc, fr, fq); S.done(cur); }
        if (!has_next) break;
#pragma unroll
        for (int a = 0; a < 2; ++a)
#pragma unroll
            for (int b = 0; b < 2; ++b)
#pragma unroll
                for (int m = 0; m < 4; ++m)
#pragma unroll
                    for (int n = 0; n < 2; ++n) acc[a][b][m][n] = (f32x4){0.f, 0.f, 0.f, 0.f};
        cur = nxt; cA = nA; cB = nB; ++ui;
        if constexpr (ALIGN_EPI) { if (wr == 1) PG8_BAR; }
    }
    PG8_WAIT_V(0);
    if constexpr (!ALIGN_EPI) { if (wr == 0) PG8_BAR; }
    PG8_BAR;
    if constexpr (Epi::AFTER_DRAIN) { E.fused(acc, cur, wr, wc, fr, fq, lds, wid, lane); S.done(cur); }
#undef PG8_SA
#undef PG8_SB
#undef PG8_STAGE
#undef PG8_LDA
#undef PG8_LDB
#undef PG8_MMA
#undef PG8_WAIT_V
#undef PG8_WAIT_L
#undef PG8_BAR
#undef PG8_SCHED
}
}
#define GAS __attribute__((address_space(1)))
#define LAS __attribute__((address_space(3)))
typedef unsigned short bf16;
typedef unsigned v4u __attribute__((ext_vector_type(4)));
typedef float f32x4 __attribute__((ext_vector_type(4)));
typedef short bf16x8 __attribute__((ext_vector_type(8)));
typedef GAS unsigned gu32;
typedef GAS unsigned long long gu64;
#define RLX_AGENT __ATOMIC_RELAXED, __HIP_MEMORY_SCOPE_AGENT
#define LDS_WAIT() asm volatile("s_waitcnt lgkmcnt(0)" ::: "memory")
#define VM_WAIT() asm volatile("s_waitcnt vmcnt(0)" ::: "memory")
__device__ __forceinline__ unsigned long long rt() { return __builtin_amdgcn_s_memrealtime(); }

#define XB_TMO      128
#define XB_XCNT(j)  (256  + 64 * (j))
#define XB_XSUB(j)  (1280 + 64 * (j))
#define XB_XGEN(j)  (2304 + 64 * (j))
#define XB_TOP      3328
#define XB_TOPGEN   3392
#define XCD_BAR_WORDS 3456
#define XB_SPIN_CAP (1u << 18)

__device__ __forceinline__ unsigned xb_ld(unsigned* p)              { return __hip_atomic_load(p, __ATOMIC_RELAXED, __HIP_MEMORY_SCOPE_AGENT); }
__device__ __forceinline__ unsigned xb_add(unsigned* p, unsigned v) { return __hip_atomic_fetch_add(p, v, __ATOMIC_RELAXED, __HIP_MEMORY_SCOPE_AGENT); }
__device__ __forceinline__ unsigned xb_xcc_id() { return (unsigned)__builtin_amdgcn_s_getreg((3 << 11) | 20) & 0xFu; }
#define XB_SPIN(cond, bar) do { unsigned _sp = 0; while (cond) { __builtin_amdgcn_s_sleep(1); \
    if ((++_sp & 255u) == 0u) { if (xb_ld(&(bar)[XB_TMO])) break; if (_sp > XB_SPIN_CAP) { atomicAdd(&(bar)[XB_TMO], 1u); break; } } } } while (0)

struct XcdBarrier {
    unsigned* bar; unsigned x;
    volatile LAS unsigned* st;
};

__device__ __forceinline__ XcdBarrier xcd_barrier_post(unsigned* bar, volatile LAS unsigned* st) {
    XcdBarrier b; b.bar = bar; b.x = xb_xcc_id(); b.st = st;
    if (threadIdx.x == 0) (void)xb_add(&bar[XB_XCNT(b.x)], 1u);
    return b;
}
__device__ __forceinline__ void xcd_barrier_complete(unsigned* bar, unsigned x, unsigned& nloc, unsigned& nx) {
    const unsigned G = gridDim.x * gridDim.y * gridDim.z;
    unsigned sum, cnt, mine, sp = 0u;
    for (;;) {
        sum = 0u; cnt = 0u; mine = 0u;
#pragma unroll
        for (unsigned j = 0; j < 16; ++j) { const unsigned c = xb_ld(&bar[XB_XCNT(j)]); sum += c; cnt += (c > 0u) ? 1u : 0u; mine = (j == x) ? c : mine; }
        if (sum == G) break;
        __builtin_amdgcn_s_sleep(1);
        if ((++sp & 255u) == 0u) { if (xb_ld(&bar[XB_TMO])) break; if (sp > XB_SPIN_CAP) { atomicAdd(&bar[XB_TMO], 1u); break; } }
    }
    nloc = mine > 0u ? mine : 1u; nx = cnt > 0u ? cnt : 1u;
}

__device__ __forceinline__ void xcd_barrier(const XcdBarrier& b) {
    asm volatile("s_waitcnt vmcnt(0)" ::: "memory");
    __syncthreads();
    if (threadIdx.x == 0) {
        unsigned* bar = b.bar;
        __builtin_amdgcn_s_waitcnt(0);
        unsigned nloc = b.st[0], nx = b.st[1];
        if (nloc == 0u) { xcd_barrier_complete(bar, b.x, nloc, nx); b.st[0] = nloc; b.st[1] = nx; }
        const unsigned old = xb_add(&bar[XB_XSUB(b.x)], 1u);
        const unsigned gen = old / nloc;
        if (old + 1u == (gen + 1u) * nloc) {
            __builtin_amdgcn_fence(__ATOMIC_RELEASE, "agent");
            asm volatile("s_waitcnt vmcnt(0)" ::: "memory");
            const unsigned og = xb_add(&bar[XB_TOP], 1u);
            const unsigned tg = og / nx;
            if (og + 1u == (tg + 1u) * nx) xb_add(&bar[XB_TOPGEN], 1u);
            else XB_SPIN(xb_ld(&bar[XB_TOPGEN]) == tg, bar);
            __builtin_amdgcn_fence(__ATOMIC_ACQUIRE, "agent");
            xb_add(&bar[XB_XGEN(b.x)], 1u);
            asm volatile("s_waitcnt vmcnt(0)" ::: "memory");
        } else {
            XB_SPIN(xb_ld(&bar[XB_XGEN(b.x)]) == gen, bar);
            __builtin_amdgcn_fence(__ATOMIC_ACQUIRE, "agent");
            asm volatile("s_waitcnt vmcnt(0)" ::: "memory");
        }
    }
    __syncthreads();
}

constexpr int RING_OFF = 0, RING_BYTES = 131072;
constexpr int RS_OFF = RING_BYTES;
constexpr int MISC_OFF = RS_OFF + 2048;
constexpr int LDS_BYTES = 163840;
constexpr int NWAVES = 8;
constexpr int CW_BAR = 1024;
static_assert(MISC_OFF + 128 <= LDS_BYTES && (CW_BAR + 4 * XCD_BAR_WORDS) * 4 <= (int)CTL_ZERO_BYTES, "maps");

struct Frame {
    LAS unsigned char* lds;
    volatile LAS unsigned* MISC;
    int tid, lane, wave, vcu, G;
};

__device__ __forceinline__ void transpose_item(const float* __restrict__ W, int ldw, int k0, int n0, bf16* WT, int ldt, int drow0, LAS float* scr, int lane) {
#pragma unroll 8
    for (int i = 0; i < 32; ++i) { const int kk = 2 * i + (lane >> 5); scr[kk * 33 + (lane & 31)] = W[(size_t)(k0 + kk) * ldw + n0 + (lane & 31)]; }
    LDS_WAIT(); asm volatile("" ::: "memory");
    const int c = lane & 7;
#pragma unroll
    for (int j = 0; j < 4; ++j) { const int n = (lane >> 3) + 8 * j; const LAS float* s = scr + (8 * c) * 33 + n;
        v4u o; o.x = pk2(s[0 * 33], s[1 * 33]); o.y = pk2(s[2 * 33], s[3 * 33]); o.z = pk2(s[4 * 33], s[5 * 33]); o.w = pk2(s[6 * 33], s[7 * 33]);
        *(GAS v4u*)(WT + (size_t)(drow0 + n) * ldt + k0 + 8 * c) = o; }
    LDS_WAIT(); asm volatile("" ::: "memory");
}
__device__ __forceinline__ int gu_row(int j) { return j < DFF ? (j >> 7) * 256 + (j & 127) : ((j - DFF) >> 7) * 256 + 128 + ((j - DFF) & 127); }

__device__ __forceinline__ void gemv4_cols32(Frame& F, const LAS float* vec, const float* __restrict__ W, int ldw, int col0, int ncols, LAS float* red) {
    const int rsub = F.lane >> 3, ch = F.lane & 7;
    float acc[4][4];
#pragma unroll
    for (int b = 0; b < 4; ++b)
#pragma unroll
        for (int e = 0; e < 4; ++e) acc[b][e] = 0.f;
    const bool on = 4 * ch < ncols;
    const float* wp = W + (size_t)(F.wave * 128 + rsub) * ldw + col0 + 4 * ch;
#pragma unroll 4
    for (int it = 0; it < 16; ++it) {
        const int k = F.wave * 128 + it * 8 + rsub;
        f32x4 wv = {0.f, 0.f, 0.f, 0.f};
        if (on) wv = *(const f32x4*)(wp + (size_t)it * 8 * ldw);
#pragma unroll
        for (int b = 0; b < 4; ++b) { const float c = vec[b * 1024 + k];
#pragma unroll
            for (int e = 0; e < 4; ++e) acc[b][e] += c * wv[e]; }
    }
#pragma unroll
    for (int b = 0; b < 4; ++b)
#pragma unroll
        for (int e = 0; e < 4; ++e) { float v = acc[b][e]; v += __shfl_xor(v, 8); v += __shfl_xor(v, 16); v += __shfl_xor(v, 32); if (rsub == 0) red[(F.wave * 8 + ch) * 16 + b * 4 + e] = v; }
    __syncthreads();
    if (F.tid < 128) { const int b = F.tid >> 5, col = F.tid & 31; float s = 0.f;
#pragma unroll
        for (int w = 0; w < 8; ++w) s += red[(w * 8 + (col >> 2)) * 16 + b * 4 + (col & 3)];
        red[1024 + F.tid] = s; }
    __syncthreads();
}

struct Args { const float* in[20]; float* out; unsigned char* ws; int ph_lo, ph_hi, li, pad; };

__device__ __forceinline__ void p0_prologue(Frame& F, const Args& a) {
    unsigned char* ws = a.ws;
    const int c = F.vcu;
    if (c < 192) {
        LAS float* vec = (LAS float*)(F.lds + RING_OFF); LAS float* red = (LAS float*)(F.lds + RING_OFF + 16384);
        for (int i = F.tid; i < 4096; i += NWAVES * 64) vec[i] = silu_f(a.in[1][i]);
        __syncthreads();
        gemv4_cols32(F, vec, a.in[2], 6144, 32 * c, 32, red);
        if (F.tid < 128) { const int b = F.tid >> 5, col = 32 * c + (F.tid & 31); ((float*)(ws + WS_MOD))[b * 6144 + col] = red[1024 + F.tid] + a.in[3][col]; }
        __syncthreads();
    }
    LAS float* scr = (LAS float*)(F.lds + RING_OFF + 32768 + F.wave * 8704);
    const int gw = c * NWAVES + F.wave, NGW = F.G * NWAVES;
    constexpr int I_IN = 16 * 72, I_O = 16 * 32, I_GU = 16 * 176, I_DN = 44 * 32, NITEMS = I_IN + I_O + I_GU + I_DN;
    for (int it = gw; it < NITEMS; it += NGW) {
        int r = it;
        if (r < I_IN) { const int kb = r / 72, nb = r % 72; transpose_item(a.in[5], NIN, 64 * kb, 32 * nb, (bf16*)(ws + WS_W1T), D, 32 * nb, scr, F.lane); continue; } r -= I_IN;
        if (r < I_O) { const int kb = r / 32, nb = r % 32; transpose_item(a.in[14], D, 64 * kb, 32 * nb, (bf16*)(ws + WS_WOT), D, 32 * nb, scr, F.lane); continue; } r -= I_O;
        if (r < I_GU) { const int kb = r / 176, nb = r % 176; transpose_item(a.in[16], NGU, 64 * kb, 32 * nb, (bf16*)(ws + WS_WGUT), D, gu_row(32 * nb), scr, F.lane); continue; } r -= I_GU;
        { const int kb = r / 32, nb = r % 32; transpose_item(a.in[17], D, 64 * kb, 32 * nb, (bf16*)(ws + WS_WDT), DFF, 32 * nb, scr, F.lane); }
    }
    if (gw < 16) { const int k = 64 * gw + F.lane; const float* wp = a.in[5] + (size_t)k * NIN + ODT; bf16* o = (bf16*)(ws + WS_W1T);
#pragma unroll
        for (int n = 0; n < 8; ++n) o[(size_t)(ODT + n) * D + k] = (bf16)f2bf(wp[n]); }
    { GAS v4u* z = (GAS v4u*)(ws + WS_W1T + (size_t)NIN * D * 2); const int nz = (NINP - NIN) * D * 2 / 16; const v4u zero = {0u, 0u, 0u, 0u};
        for (int i = gw * 64 + F.lane; i < nz; i += NGW * 64) z[i] = zero; }
}

__device__ __forceinline__ void p0b_rows(Frame& F, const Args& a) {
    unsigned char* ws = a.ws;
    const float* MOD = (const float*)(ws + WS_MOD);
    const int c = F.vcu;
    if (c < 249) {
        LAS float* vec = (LAS float*)(F.lds + RING_OFF); LAS float* red = (LAS float*)(F.lds + RING_OFF + 16384);
        const bool first = c < 73; const int soff = first ? 0 : 3072;
        for (int i = F.tid; i < 4096; i += NWAVES * 64) vec[i] = MOD[(i >> 10) * 6144 + soff + (i & 1023)];
        __syncthreads();
        if (first) {
            const int col0 = 32 * c, nc = (NIN - col0) < 32 ? (NIN - col0) : 32;
            gemv4_cols32(F, vec, a.in[5], NIN, col0, nc, red);
            if (F.tid < 128) { const int b = F.tid >> 5, j = F.tid & 31; ((float*)(ws + WS_BIAS1))[b * NINP + col0 + j] = (j < nc) ? red[1024 + F.tid] : 0.f; }
        } else {
            const int col0 = 32 * (c - 73);
            gemv4_cols32(F, vec, a.in[16], NGU, col0, 32, red);
            if (F.tid < 128) { const int b = F.tid >> 5, j = F.tid & 31; ((float*)(ws + WS_BIAS2))[b * NGU + gu_row(col0 + j)] = red[1024 + F.tid]; }
        }
        __syncthreads();
    } else if (c == 255) {
        for (int i = F.tid; i < 4 * (NINP - 2336); i += NWAVES * 64) { const int b = i / (NINP - 2336), j = i % (NINP - 2336); ((float*)(ws + WS_BIAS1))[b * NINP + 2336 + j] = 0.f; }
        for (int i = F.tid; i < 4096; i += NWAVES * 64) { const int b = i >> 10, k = i & 1023; ((float*)(ws + WS_GM2))[i] = a.in[15][k] * (1.f + MOD[b * 6144 + 4096 + k]); }
    }
    const int gw = c * NWAVES + F.wave;
    const int b = gw >> 9;
    f32x4 gm[4];
#pragma unroll
    for (int j = 0; j < 4; ++j) { const f32x4 g = *(const f32x4*)(a.in[4] + 4 * F.lane + 256 * j), s = *(const f32x4*)(MOD + b * 6144 + 1024 + 4 * F.lane + 256 * j); gm[j] = g * (1.f + s); }
    bf16* A1 = (bf16*)(ws + WS_A); float* RSTD = (float*)(ws + WS_RSTD1);
#pragma unroll 2
    for (int rr = 0; rr < 16; ++rr) {
        const size_t row = (size_t)gw * 16 + rr;
        const GAS f32x4* xr = (const GAS f32x4*)(a.in[0] + row * D) + F.lane;
        f32x4 v[4]; float s = 0.f;
#pragma unroll
        for (int j = 0; j < 4; ++j) { v[j] = xr[64 * j]; s += (v[j].x * v[j].x + v[j].y * v[j].y) + (v[j].z * v[j].z + v[j].w * v[j].w); }
        const float tot = wave_sum(s);
        if (F.lane == 0) RSTD[row] = rsqrtf(tot * (1.f / D) + EPS);
        GAS unsigned long long* o8 = (GAS unsigned long long*)(A1 + row * D) + F.lane;
#pragma unroll
        for (int j = 0; j < 4; ++j) { const f32x4 o = v[j] * gm[j]; o8[64 * j] = (unsigned long long)pk2(o.x, o.y) | ((unsigned long long)pk2(o.z, o.w) << 32); }
    }
}

__device__ __forceinline__ void p6_final(Frame& F, const Args& a) {
    const int gw = F.vcu * NWAVES + F.wave;
    f32x4 gf[4];
#pragma unroll
    for (int j = 0; j < 4; ++j) gf[j] = *(const f32x4*)(a.in[19] + 4 * F.lane + 256 * j);
#pragma unroll 2
    for (int rr = 0; rr < 16; ++rr) {
        const size_t row = (size_t)gw * 16 + rr;
        GAS f32x4* xr = (GAS f32x4*)(a.out + row * D) + F.lane;
        f32x4 v[4]; float s = 0.f;
#pragma unroll
        for (int j = 0; j < 4; ++j) { v[j] = xr[64 * j]; s += (v[j].x * v[j].x + v[j].y * v[j].y) + (v[j].z * v[j].z + v[j].w * v[j].w); }
        const float rstd = rsqrtf(wave_sum(s) * (1.f / D) + EPS);
#pragma unroll
        for (int j = 0; j < 4; ++j) xr[64 * j] = v[j] * rstd * gf[j];
    }
}


constexpr int XT_OFF = MISC_OFF + 256;
constexpr int AT_K = 0, AT_V = 65536;
constexpr int AT_BT = XT_OFF;
constexpr int AT_GA = AT_BT + 4096;
constexpr int AT_RED = AT_GA + 2048;
constexpr int SS_XS = 0, SS_B = 65536, SS_C = 98304;
constexpr int SS_ACS = XT_OFF;
constexpr int SS_DT = SS_ACS + 2048;
constexpr int SS_WSC = SS_DT + 2048;
constexpr int SS_RED = SS_WSC + 2048;
constexpr size_t WS_STATES = WS_SSD;
constexpr size_t WS_CD = WS_SSD + 32 * MiB;

namespace mix {
typedef float f32x16 __attribute__((ext_vector_type(16)));
typedef short s16x8 __attribute__((ext_vector_type(8)));
typedef short s16x4 __attribute__((ext_vector_type(4)));
typedef unsigned u32x2 __attribute__((ext_vector_type(2)));
typedef unsigned u32x4 __attribute__((ext_vector_type(4)));
typedef float f32x2_t __attribute__((ext_vector_type(2))); typedef __bf16 bf16x2_t __attribute__((ext_vector_type(2)));
__device__ __forceinline__ unsigned cvtpk(float lo, float hi) { f32x2_t v = {lo, hi}; bf16x2_t b = __builtin_convertvector(v, bf16x2_t); return __builtin_bit_cast(unsigned, b); }
__device__ __forceinline__ int crow(int r, int hi) { return (r & 3) + 8 * (r >> 2) + 4 * hi; }
__device__ __forceinline__ s16x4 vtr(const LAS unsigned char* p) { return __builtin_bit_cast(s16x4, __builtin_amdgcn_ds_read_tr16_b64_v4i16((LAS s16x4*)p)); }
__device__ __forceinline__ s16x8 tr_pair(const LAS unsigned char* plo, const LAS unsigned char* phi) { const s16x4 a = vtr(plo), b = vtr(phi); return (s16x8){a[0], a[1], a[2], a[3], b[0], b[1], b[2], b[3]}; }
__device__ __forceinline__ s16x8 pack8(const f32x16& v, int base) {
    u32x4 w; w.x = cvtpk(v[base + 0], v[base + 1]); w.y = cvtpk(v[base + 2], v[base + 3]); w.z = cvtpk(v[base + 4], v[base + 5]); w.w = cvtpk(v[base + 6], v[base + 7]);
    return __builtin_bit_cast(s16x8, w);
}
#define MFMA32(a, b, c) __builtin_amdgcn_mfma_f32_32x32x16_bf16((a), (b), (c), 0, 0, 0)

__device__ __forceinline__ void attn_unit(Frame& F, const Args& a, int b, int n) {
    unsigned char* ws = a.ws;
    const bf16* PROJ = (const bf16*)(ws + WS_PROJ);
    bf16* YMIX = (bf16*)(ws + WS_YMIX);
    LAS unsigned char* lds = F.lds;
    const int t0 = b * SEQ + n * 128, tid = F.tid, lane = F.lane, head = F.wave, kvh = head >> 2, ql = lane & 31, hi = lane >> 5;
    const bool first = (n == 0);
    {
        u32x4 v[16];
#pragma unroll
        for (int i = 0; i < 16; ++i) { const int idx = tid + i * 512, key = idx >> 5, ch = idx & 31;
            v[i] = (first && key < 128) ? (u32x4){0u, 0u, 0u, 0u} : *(const u32x4*)(PROJ + (size_t)(t0 - 128 + key) * NINP + OK_ + ch * 8); }
#pragma unroll
        for (int i = 0; i < 16; ++i) { const int idx = tid + i * 512, key = idx >> 5, ch = idx & 31; int dst;
            if (ch < 16) dst = AT_K + key * 256 + ((ch ^ (key & 15)) << 4);
            else { const int c = ch - 16; dst = AT_V + key * 256 + ((((c >> 2) ^ (key & 3)) << 6) | ((c & 3) << 4)); }
            *(LAS u32x4*)(lds + dst) = v[i]; }
        LAS float* bt = (LAS float*)(lds + AT_BT); LAS float* ga = (LAS float*)(lds + AT_GA);
        for (int i = tid; i < 1024; i += 512) bt[i] = a.in[18][T5B[i & 127] * 8 + (i >> 7)] * LOG2E;
        ga[tid] = a.in[12][tid];
    }
    __syncthreads();
    const LAS float* bt = (const LAS float*)(lds + AT_BT) + head * 128;
    const LAS float* ga = (const LAS float*)(lds + AT_GA) + head * 64;
    const float sink2 = a.in[11][head] * LOG2E;
#pragma unroll 1
    for (int qb = 0; qb < 4; ++qb) {
        s16x8 qf[4];
        { const bf16* qp = PROJ + (size_t)(t0 + 32 * qb + ql) * NINP + head * 64 + 8 * hi;
#pragma unroll
          for (int s = 0; s < 4; ++s) qf[s] = *(const s16x8*)(qp + 16 * s); }
        f32x16 S[5];
#pragma unroll
        for (int kk = 0; kk < 5; ++kk) {
            const LAS unsigned char* kbase = lds + AT_K + (32 * (qb + kk) + ql) * 256;
            f32x16 acc = {};
#pragma unroll
            for (int s = 0; s < 4; ++s) { const int ch = kvh * 8 + 2 * s + hi; const s16x8 kf = *(const LAS s16x8*)(kbase + ((ch ^ (ql & 15)) << 4)); acc = MFMA32(kf, qf[s], acc); }
            S[kk] = acc;
        }
        float m = sink2;
#pragma unroll
        for (int kk = 0; kk < 5; ++kk) {
            const bool dead = first && (qb + kk) < 4;
#pragma unroll
            for (int r = 0; r < 16; ++r) {
                const int cr = crow(r, hi), dist = 32 * (4 - kk) + ql - cr;
                bool valid = !dead;
                if (kk == 0) valid = valid && (cr > ql);
                if (kk == 4) valid = valid && (cr <= ql);
                const float v = valid ? S[kk][r] + bt[dist & 127] : -INFINITY;
                S[kk][r] = v; m = fmaxf(m, v);
            }
        }
        m = fmaxf(m, __shfl_xor(m, 32));
        float lsum = 0.f;
#pragma unroll
        for (int kk = 0; kk < 5; ++kk)
#pragma unroll
            for (int r = 0; r < 16; ++r) { const float p = __builtin_amdgcn_exp2f(S[kk][r] - m); S[kk][r] = p; lsum += p; }
        lsum += __shfl_xor(lsum, 32);
        const float rden = 1.f / (lsum + __builtin_amdgcn_exp2f(sink2 - m));
        f32x16 O[2]; O[0] = (f32x16){}; O[1] = (f32x16){};
#pragma unroll
        for (int kk = 0; kk < 5; ++kk)
#pragma unroll
            for (int k2 = 0; k2 < 2; ++k2) {
                const s16x8 pa = pack8(S[kk], 8 * k2);
                const int row = 32 * (qb + kk) + 16 * k2 + 4 * hi + ((lane & 15) >> 2);
#pragma unroll
                for (int db = 0; db < 2; ++db) {
                    const int cbyte = (kvh * 64 + db * 32 + 16 * ((lane >> 4) & 1) + 4 * (lane & 3)) * 2;
                    const LAS unsigned char* p = lds + AT_V + row * 256 + ((((cbyte >> 6) ^ (row & 3)) << 6) | (cbyte & 63));
                    const s16x8 vf = tr_pair(p, p + 8 * 256);
                    O[db] = MFMA32(vf, pa, O[db]);
                }
            }
        float ss = 0.f;
#pragma unroll
        for (int db = 0; db < 2; ++db)
#pragma unroll
            for (int r = 0; r < 16; ++r) { const float o = O[db][r] * rden; O[db][r] = o; ss += o * o; }
        ss += __shfl_xor(ss, 32);
        LAS float* red = (LAS float*)(lds + AT_RED) + (qb & 1) * 1024;
        if (hi == 0) red[(32 * qb + ql) * 8 + head] = ss;
        __syncthreads();
        const f32x4 r0 = *(const LAS f32x4*)&red[(32 * qb + ql) * 8], r1 = *(const LAS f32x4*)&red[(32 * qb + ql) * 8 + 4];
        const float rstd = rsqrtf((((r0[0] + r0[1]) + (r0[2] + r0[3])) + ((r1[0] + r1[1]) + (r1[2] + r1[3]))) * (1.f / 512.f) + EPS);
        bf16* yp = YMIX + (size_t)(t0 + 32 * qb + ql) * D + head * 64;
#pragma unroll
        for (int db = 0; db < 2; ++db)
#pragma unroll
            for (int r4 = 0; r4 < 4; ++r4) {
                const int d0 = 32 * db + 8 * r4 + 4 * hi;
                const f32x4 g = *(const LAS f32x4*)&ga[d0];
                u32x2 w; w.x = cvtpk(O[db][4 * r4 + 0] * rstd * g[0], O[db][4 * r4 + 1] * rstd * g[1]); w.y = cvtpk(O[db][4 * r4 + 2] * rstd * g[2], O[db][4 * r4 + 3] * rstd * g[3]);
                *(u32x2*)(yp + d0) = w;
            }
    }
    __syncthreads();
}

__device__ __forceinline__ void ssd_dt_scan(Frame& F, const Args& a, int t0, int g, int bc  , bool write_cd) {
    LAS float* acs = (LAS float*)(F.lds + SS_ACS); LAS float* dts = (LAS float*)(F.lds + SS_DT); LAS float* wsc = (LAS float*)(F.lds + SS_WSC);
    if (F.wave < 4) {
        const int hd = 4 * g + F.wave, lane = F.lane;
        const float A = -expf(a.in[9][hd]), dtb = a.in[8][hd];
        const float* DT = (const float*)(a.ws + WS_DT);
        const float d0 = softplus_f(DT[(size_t)(t0 + 2 * lane) * 8 + hd] + dtb), d1 = softplus_f(DT[(size_t)(t0 + 2 * lane + 1) * 8 + hd] + dtb);
        const float a0 = d0 * A, a1 = d1 * A;
        float x = a0 + a1;
#pragma unroll
        for (int o = 1; o < 64; o <<= 1) { const float t = __shfl_up(x, o); if (lane >= o) x += t; }
        const float c0 = (x - a1) * LOG2E, c1 = x * LOG2E, last = __shfl(x, 63) * LOG2E;
        acs[F.wave * 128 + 2 * lane] = c0; acs[F.wave * 128 + 2 * lane + 1] = c1;
        dts[F.wave * 128 + 2 * lane] = d0; dts[F.wave * 128 + 2 * lane + 1] = d1;
        wsc[F.wave * 128 + 2 * lane] = d0 * __builtin_amdgcn_exp2f(last - c0); wsc[F.wave * 128 + 2 * lane + 1] = d1 * __builtin_amdgcn_exp2f(last - c1);
        if (write_cd && lane == 0) ((float*)(a.ws + WS_CD))[bc * 8 + hd] = __builtin_amdgcn_exp2f(last);
    }
}

template <int MODE>
__device__ __forceinline__ void ssd_stage(Frame& F, const Args& a, int t0, int c, int g) {
    const bf16* PROJ = (const bf16*)(a.ws + WS_PROJ);
    const int cc = F.lane, rs = F.wave;
    if (MODE == 0 && cc >= 48) return;
    int pcol, xcol;
    if (cc < 32) { xcol = g * 256 + 8 * cc; } else if (cc < 48) { xcol = 512 + g * 128 + 8 * (cc - 32); } else { xcol = 768 + g * 128 + 8 * (cc - 48); }
    pcol = OXBC + xcol;
    u32x4 raw[19];
#pragma unroll
    for (int k = 0; k < 19; ++k) { const int lrow = 16 * rs - 3 + k;
        raw[k] = (c == 0 && lrow < 0) ? (u32x4){0u, 0u, 0u, 0u} : *(const u32x4*)(PROJ + (size_t)(t0 + lrow) * NINP + pcol); }
    float cw[4][8], cb[8];
#pragma unroll
    for (int j = 0; j < 4; ++j) { const f32x4 w0 = *(const f32x4*)(a.in[6] + j * 1024 + xcol), w1 = *(const f32x4*)(a.in[6] + j * 1024 + xcol + 4);
#pragma unroll
        for (int e = 0; e < 4; ++e) { cw[j][e] = w0[e]; cw[j][4 + e] = w1[e]; } }
    { const f32x4 b0 = *(const f32x4*)(a.in[7] + xcol), b1 = *(const f32x4*)(a.in[7] + xcol + 4);
#pragma unroll
      for (int e = 0; e < 4; ++e) { cb[e] = b0[e]; cb[4 + e] = b1[e]; } }
    const LAS float* wsc = (const LAS float*)(F.lds + SS_WSC) + (cc >> 3) * 128;
#pragma unroll
    for (int i = 0; i < 16; ++i) {
        const int l = 16 * rs + i;
        float o[8];
#pragma unroll
        for (int e = 0; e < 8; ++e) o[e] = cb[e];
#pragma unroll
        for (int j = 0; j < 4; ++j) {
            const u32x4 rv = raw[i + j];
#pragma unroll
            for (int e2 = 0; e2 < 4; ++e2) { const unsigned u = rv[e2]; o[2 * e2] += cw[j][2 * e2] * __uint_as_float(u << 16); o[2 * e2 + 1] += cw[j][2 * e2 + 1] * __uint_as_float(u & 0xffff0000u); }
        }
        float sc = 1.f;
        if (MODE == 0 && cc < 32) sc = wsc[l];
#pragma unroll
        for (int e = 0; e < 8; ++e) o[e] = o[e] * __builtin_amdgcn_rcpf(1.f + __builtin_amdgcn_exp2f(-LOG2E * o[e])) * sc;
        u32x4 w; w.x = cvtpk(o[0], o[1]); w.y = cvtpk(o[2], o[3]); w.z = cvtpk(o[4], o[5]); w.w = cvtpk(o[6], o[7]);
        int dst;
        if (cc < 32) { const int cbyte = cc * 16; dst = SS_XS + l * 512 + ((((cbyte >> 6) ^ (l & 3)) << 6) | (cbyte & 63)); }
        else if (cc < 48) { const int ch = cc - 32; dst = SS_B + l * 256 + (MODE == 0 ? ((((ch >> 2) ^ (l & 3)) << 6) | ((ch & 3) << 4)) : ((ch ^ (l & 15)) << 4)); }
        else { const int ch = cc - 48; dst = SS_C + l * 256 + ((ch ^ (l & 15)) << 4); }
        *(LAS u32x4*)(F.lds + dst) = w;
    }
}

__device__ __forceinline__ void ssd_states_unit(Frame& F, const Args& a, int b, int c, int g) {
    const int t0 = b * SEQ + c * 128, lane = F.lane, hi = lane >> 5;
    LAS unsigned char* lds = F.lds;
    ssd_dt_scan(F, a, t0, g, b * 64 + c, true);
    __syncthreads();
    ssd_stage<0>(F, a, t0, c, g);
    __syncthreads();
    const int hl = F.wave >> 1, ph = F.wave & 1, hd = 4 * g + hl;
    const int rq = (lane & 15) >> 2, csub = 16 * ((lane >> 4) & 1) + 4 * (lane & 3);
    s16x8 xf[8];
    { const int cbyte = (hl * 64 + 32 * ph + csub) * 2;
#pragma unroll
      for (int ks = 0; ks < 8; ++ks) { const int row = 16 * ks + 8 * hi + rq; const LAS unsigned char* p = lds + SS_XS + row * 512 + ((((cbyte >> 6) ^ (row & 3)) << 6) | (cbyte & 63)); xf[ks] = tr_pair(p, p + 4 * 512); } }
    bf16* ST = (bf16*)(a.ws + WS_STATES) + ((size_t)((b * 64 + c) * 8 + hd) * 64 + 32 * ph + (lane & 31)) * 128;
#pragma unroll
    for (int nb = 0; nb < 4; ++nb) {
        f32x16 acc = {};
        const int cbyte = (32 * nb + csub) * 2;
#pragma unroll
        for (int ks = 0; ks < 8; ++ks) { const int row = 16 * ks + 8 * hi + rq; const LAS unsigned char* p = lds + SS_B + row * 256 + ((((cbyte >> 6) ^ (row & 3)) << 6) | (cbyte & 63));
            const s16x8 bfr = tr_pair(p, p + 4 * 256); acc = MFMA32(bfr, xf[ks], acc); }
#pragma unroll
        for (int r4 = 0; r4 < 4; ++r4) { u32x2 w; w.x = cvtpk(acc[4 * r4], acc[4 * r4 + 1]); w.y = cvtpk(acc[4 * r4 + 2], acc[4 * r4 + 3]); *(u32x2*)(ST + 32 * nb + 8 * r4 + 4 * hi) = w; }
    }
    __syncthreads();
}

__device__ __forceinline__ void ssd_scan(Frame& F, const Args& a) {
    const int idx = F.vcu * (NWAVES * 64) + F.tid;
    const int np = idx & 63, p = (idx >> 6) & 63, hd = (idx >> 12) & 7, b = idx >> 15;
    unsigned* ST = (unsigned*)(a.ws + WS_STATES) + (((size_t)(b * 64) * 8 + hd) * 8192 + p * 128 + 2 * np) / 2;
    const float* CD = (const float*)(a.ws + WS_CD) + b * 512 + hd;
    float h0 = 0.f, h1 = 0.f;
#pragma unroll 1
    for (int c0 = 0; c0 < 64; c0 += 16) {
        unsigned v[16]; float cd[16];
#pragma unroll
        for (int i = 0; i < 16; ++i) { v[i] = ST[(size_t)(c0 + i) * 32768]; cd[i] = CD[(c0 + i) * 8]; }
#pragma unroll
        for (int i = 0; i < 16; ++i) {
            ST[(size_t)(c0 + i) * 32768] = mix::cvtpk(h0, h1);
            h0 = h0 * cd[i] + __uint_as_float(v[i] << 16); h1 = h1 * cd[i] + __uint_as_float(v[i] & 0xffff0000u);
        }
    }
}

__device__ __forceinline__ void ssd_out_unit(Frame& F, const Args& a, int b, int c, int g) {
    const int t0 = b * SEQ + c * 128, lane = F.lane, hi = lane >> 5;
    LAS unsigned char* lds = F.lds;
    const bf16* PROJ = (const bf16*)(a.ws + WS_PROJ);
    bf16* YMIX = (bf16*)(a.ws + WS_YMIX);
    ssd_dt_scan(F, a, t0, g, b * 64 + c, false);
    ssd_stage<1>(F, a, t0, c, g);
    __syncthreads();
    const int hl = F.wave >> 1, lp = F.wave & 1, hd = 4 * g + hl;
    const LAS float* acs = (const LAS float*)(lds + SS_ACS) + hl * 128; const LAS float* dts = (const LAS float*)(lds + SS_DT) + hl * 128;
    const float Dk = a.in[10][hd];
    const int rq = (lane & 15) >> 2, csub = 16 * ((lane >> 4) & 1) + 4 * (lane & 3);
    const bf16* PV = (const bf16*)(a.ws + WS_STATES) + ((size_t)((b * 64 + c) * 8 + hd) * 64) * 128;
#pragma unroll 1
    for (int it = 0; it < 2; ++it) {
        const int lblk = (it == 0) ? lp : 3 - lp, lrow = 32 * lblk + (lane & 31);
        s16x8 cf[8];
#pragma unroll
        for (int ks = 0; ks < 8; ++ks) cf[ks] = *(const LAS s16x8*)(lds + SS_C + lrow * 256 + (((2 * ks + hi) ^ (lrow & 15)) << 4));
        f32x16 acc[2]; acc[0] = (f32x16){}; acc[1] = (f32x16){};
        const float al = acs[lrow];
        if (c > 0) {
#pragma unroll
            for (int ks = 0; ks < 8; ++ks)
#pragma unroll
                for (int pb = 0; pb < 2; ++pb) { const s16x8 ap = *(const s16x8*)(PV + (32 * pb + (lane & 31)) * 128 + 16 * ks + 8 * hi); acc[pb] = MFMA32(ap, cf[ks], acc[pb]); }
            const float ea = __builtin_amdgcn_exp2f(al);
            acc[0] = acc[0] * ea; acc[1] = acc[1] * ea;
        }
#pragma unroll 1
        for (int sb = 0; sb <= lblk; ++sb) {
            f32x16 cbt = {};
            const int srow = 32 * sb + (lane & 31);
#pragma unroll
            for (int ks = 0; ks < 8; ++ks) { const s16x8 bfr = *(const LAS s16x8*)(lds + SS_B + srow * 256 + (((2 * ks + hi) ^ (srow & 15)) << 4)); cbt = MFMA32(bfr, cf[ks], cbt); }
#pragma unroll
            for (int r = 0; r < 16; ++r) { const int s = 32 * sb + crow(r, hi); const float v = cbt[r] * __builtin_amdgcn_exp2f(al - acs[s]) * dts[s]; cbt[r] = (s <= lrow) ? v : 0.f; }
#pragma unroll
            for (int k2 = 0; k2 < 2; ++k2) {
                const s16x8 pw = pack8(cbt, 8 * k2);
                const int row = 32 * sb + 16 * k2 + 4 * hi + rq;
#pragma unroll
                for (int pb = 0; pb < 2; ++pb) { const int cbyte = (hl * 64 + 32 * pb + csub) * 2; const LAS unsigned char* p = lds + SS_XS + row * 512 + ((((cbyte >> 6) ^ (row & 3)) << 6) | (cbyte & 63));
                    const s16x8 xa = tr_pair(p, p + 8 * 512); acc[pb] = MFMA32(xa, pw, acc[pb]); }
            }
        }
        float ss = 0.f;
        const bf16* zp = PROJ + (size_t)(t0 + lrow) * NINP + OZ + g * 256 + hl * 64;
#pragma unroll
        for (int pb = 0; pb < 2; ++pb)
#pragma unroll
            for (int r4 = 0; r4 < 4; ++r4) {
                const int p0 = 32 * pb + 8 * r4 + 4 * hi, cbyte = (hl * 64 + p0) * 2;
                const u32x2 xv = *(const LAS u32x2*)(lds + SS_XS + lrow * 512 + ((((cbyte >> 6) ^ (lrow & 3)) << 6) | (cbyte & 63)));
                const u32x2 zv = *(const u32x2*)(zp + p0);
                const float xs[4] = {__uint_as_float(xv.x << 16), __uint_as_float(xv.x & 0xffff0000u), __uint_as_float(xv.y << 16), __uint_as_float(xv.y & 0xffff0000u)};
                const float zs[4] = {__uint_as_float(zv.x << 16), __uint_as_float(zv.x & 0xffff0000u), __uint_as_float(zv.y << 16), __uint_as_float(zv.y & 0xffff0000u)};
#pragma unroll
                for (int e = 0; e < 4; ++e) { float y = acc[pb][4 * r4 + e] + Dk * xs[e]; y *= zs[e] * __builtin_amdgcn_rcpf(1.f + __builtin_amdgcn_exp2f(-LOG2E * zs[e])); acc[pb][4 * r4 + e] = y; ss += y * y; }
            }
        ss += __shfl_xor(ss, 32);
        LAS float* red = (LAS float*)(lds + SS_RED) + it * 512;
        if (hi == 0) red[lrow * 4 + hl] = ss;
        __syncthreads();
        const f32x4 rr = *(const LAS f32x4*)&red[lrow * 4];
        const float rstd = rsqrtf(((rr[0] + rr[1]) + (rr[2] + rr[3])) * (1.f / 256.f) + EPS);
        bf16* yp = YMIX + (size_t)(t0 + lrow) * D + 512 + g * 256 + hl * 64;
        const float* gs = a.in[13] + g * 256 + hl * 64;
#pragma unroll
        for (int pb = 0; pb < 2; ++pb)
#pragma unroll
            for (int r4 = 0; r4 < 4; ++r4) {
                const int p0 = 32 * pb + 8 * r4 + 4 * hi;
                const f32x4 gv = *(const f32x4*)(gs + p0);
                u32x2 w; w.x = cvtpk(acc[pb][4 * r4] * rstd * gv[0], acc[pb][4 * r4 + 1] * rstd * gv[1]); w.y = cvtpk(acc[pb][4 * r4 + 2] * rstd * gv[2], acc[pb][4 * r4 + 3] * rstd * gv[3]);
                *(u32x2*)(yp + p0) = w;
            }
    }
    __syncthreads();
}
#undef MFMA32
}
#ifndef MIX_STEP
#define MIX_STEP 2
#endif
__global__ void __launch_bounds__(NWAVES * 64, 2) mk_fwd(Args args) {
    extern __shared__ __attribute__((aligned(16))) unsigned char lds[];
    Frame F;
    F.lds = (LAS unsigned char*)lds;
    F.MISC = (volatile LAS unsigned*)(F.lds + MISC_OFF);
    F.tid = threadIdx.x; F.lane = F.tid & 63; F.wave = __builtin_amdgcn_readfirstlane(F.tid >> 6);
    F.G = gridDim.x; { const int bx = blockIdx.x; F.vcu = (bx % 8) * (F.G / 8) + bx / 8; }
    unsigned char* ws = args.ws;
    gu32* ctl = (gu32*)(ws + WS_CTL);
    for (int u = F.tid; u < (LDS_BYTES - MISC_OFF) / 4; u += NWAVES * 64) ((LAS unsigned*)(F.lds + MISC_OFF))[u] = 0u;
    __syncthreads();
    XcdBarrier bar = xcd_barrier_post((unsigned*)(ctl + CW_BAR) + args.li * XCD_BAR_WORDS, F.MISC + 8);
    const int lo = args.ph_lo, hi = args.ph_hi;
#define IN(k) (lo <= (k) && (k) < hi)
#define BOTH(k) (IN(k) && IN((k) + 1))
#define GRID_BAR() xcd_barrier(bar)
    LAS float* rs = (LAS float*)(F.lds + RS_OFF);
    const int pA = 2 * (F.vcu >> 2);

    if (IN(0)) { p0_prologue(F, args); if (BOTH(0)) GRID_BAR(); }
    if (IN(1)) { p0b_rows(F, args); if (BOTH(1)) GRID_BAR(); }
    if (IN(2)) {
        rs[F.tid] = ((const float*)(ws + WS_RSTD1))[pA * 256 + F.tid];
        __syncthreads();
        pg8::Gemm g{(const bf16*)(ws + WS_A), (const bf16*)(ws + WS_W1T), T, NINP, D}; pg8::QuadOrder S; S.init(NINP, F.vcu);
        pg8::EpiIn E{(bf16*)(ws + WS_PROJ), (const float*)(ws + WS_BIAS1), (float*)(ws + WS_DT), rs};
        pg8::gemm_phase<pg8::EpiIn, pg8::QuadOrder, true, true>(F.lds + RING_OFF, g, S, E);
        if (BOTH(2)) GRID_BAR();
    }
    if (IN(3)) {
        mix::attn_unit(F, args, F.vcu >> 6, F.vcu & 63);
#if MIX_STEP >= 2
        for (int i = 0; i < 2; ++i) { const int u = 2 * F.vcu + i; mix::ssd_states_unit(F, args, u >> 7, (u >> 1) & 63, u & 1); }
#endif
        if (BOTH(3)) GRID_BAR();
    }
#if MIX_STEP >= 2
    if (IN(4)) { mix::ssd_scan(F, args); if (BOTH(4)) GRID_BAR(); }
    if (IN(5)) {
        for (int i = 0; i < 2; ++i) { const int u = 2 * F.vcu + i; mix::ssd_out_unit(F, args, u >> 7, (u >> 1) & 63, u & 1); }
        if (BOTH(5)) GRID_BAR();
    }
#endif
    if (IN(6)) {
        pg8::Gemm g{(const bf16*)(ws + WS_YMIX), (const bf16*)(ws + WS_WOT), T, D, D}; pg8::QuadOrder S; S.init(D, F.vcu);
        pg8::EpiWo E{args.in[0], args.out, (bf16*)(ws + WS_A), (float*)(ws + WS_SS2), (const float*)(ws + WS_MOD) + 2048, (const float*)(ws + WS_GM2)};
        pg8::gemm_phase<pg8::EpiWo, pg8::QuadOrder, true, true>(F.lds + RING_OFF, g, S, E);
        if (BOTH(6)) GRID_BAR();
    }
    if (IN(7)) {
        { const f32x4* p = (const f32x4*)((const float*)(ws + WS_SS2) + (size_t)(pA * 256 + F.tid) * 16); const f32x4 s0 = p[0], s1 = p[1], s2 = p[2], s3 = p[3];
          const f32x4 t = (s0 + s1) + (s2 + s3); rs[F.tid] = rsqrtf(((t[0] + t[1]) + (t[2] + t[3])) * (1.f / D) + EPS); }
        __syncthreads();
        pg8::Gemm g{(const bf16*)(ws + WS_A), (const bf16*)(ws + WS_WGUT), T, NGU, D}; pg8::QuadOrder S; S.init(NGU, F.vcu);
        pg8::EpiGU E{(bf16*)(ws + WS_ACT), (const float*)(ws + WS_BIAS2), rs};
        pg8::gemm_phase<pg8::EpiGU, pg8::QuadOrder, true, true>(F.lds + RING_OFF, g, S, E);
        if (BOTH(7)) GRID_BAR();
    }
    if (IN(8)) {
        pg8::Gemm g{(const bf16*)(ws + WS_ACT), (const bf16*)(ws + WS_WDT), T, D, DFF}; pg8::QuadOrder S; S.init(D, F.vcu);
        pg8::EpiDown E{args.out, (const float*)(ws + WS_MOD) + 5120};
        pg8::gemm_phase<pg8::EpiDown, pg8::QuadOrder, true, true>(F.lds + RING_OFF, g, S, E);
        if (BOTH(8)) GRID_BAR();
    }
    if (IN(9)) p6_final(F, args);
#undef IN
#undef BOTH
#undef GRID_BAR
}

extern "C" void kernel_launch(void* const* d_in, const int* in_sizes, int n_in, void* d_out, int out_size, void* d_ws, size_t ws_size, hipStream_t stream) {
    static int grid = 0;
    if (grid == 0) {
        if (n_in != 20 || in_sizes[0] != T * D || out_size != T * D || ws_size < WS_END) { fprintf(stderr, "kernel_launch: unexpected shapes (n_in %d, ws %zu)\n", n_in, ws_size); grid = -1; return; }
        int dev = 0, cus = 0;
        if (hipGetDevice(&dev) != hipSuccess || hipDeviceGetAttribute(&cus, hipDeviceAttributeMultiprocessorCount, dev) != hipSuccess) { grid = -1; return; }
        if (hipFuncSetAttribute((const void*)mk_fwd, hipFuncAttributeMaxDynamicSharedMemorySize, LDS_BYTES) != hipSuccess) { fprintf(stderr, "kernel_launch: hipFuncSetAttribute failed\n"); grid = -1; return; }
        grid = cus;
        if (grid != 256) fprintf(stderr, "kernel_launch: %d CUs; this kernel is laid out for 256\n", grid);
    }
    if (grid < 0) return;
    (void)hipMemsetAsync((char*)d_ws + WS_CTL, 0, CTL_ZERO_BYTES, stream);
    Args a{};
    for (int i = 0; i < 20; ++i) a.in[i] = (const float*)d_in[i];
    a.out = (float*)d_out; a.ws = (unsigned char*)d_ws;
    unsigned char* ws = (unsigned char*)d_ws;
#if MIX_STEP >= 2
    a.ph_lo = 0; a.ph_hi = 10; a.li = 0;
    hipLaunchKernelGGL(mk_fwd, dim3(grid), dim3(NWAVES * 64), LDS_BYTES, stream, a);
#else
    a.ph_lo = 0; a.ph_hi = 4; a.li = 0;
    hipLaunchKernelGGL(mk_fwd, dim3(grid), dim3(NWAVES * 64), LDS_BYTES, stream, a);
    {
        const bf16* PROJ = (const bf16*)(ws + WS_PROJ); float* YF = (float*)(ws + WS_SSD); float* XC = (float*)d_out;
        k_conv<<<T, 256, 0, stream>>>(PROJ, a.in[6], a.in[7], XC);
        k_ssd_seq<<<BATCH * 8 * 64, 64, 0, stream>>>((const float*)(ws + WS_DT), XC, a.in[8], a.in[9], a.in[10], YF);
        k_mixnorm<<<T, 256, 0, stream>>>(PROJ, a.in[12], a.in[13], YF, (bf16*)(ws + WS_YMIX), 1);
    }
    a.ph_lo = 6; a.ph_hi = 10; a.li = 1;
    hipLaunchKernelGGL(mk_fwd, dim3(grid), dim3(NWAVES * 64), LDS_BYTES, stream, a);
#endif
}
```
